# Optimizing an MI355X kernel written in HIP

```python
import math
import jax, jax.numpy as jnp
from jax import lax
import numpy as np

D_MODEL = 1024
BATCH = 8
SEQ = 4096
DEPTH = 2

GRID_W = 64
CTX_LEN = 256
HEAD_DIM = 64
NA_HEADS = 4
NA_WIN_R = 8
NA_WIN_C = 16
GQA_Q_HEADS = 4
GQA_KV_HEADS = 2
DN_HEADS = 4
DN_CONV = 5
DN_CHUNK = 64
MLA_HEADS = 4
MLA_Q_RANK = 256
MLA_KV_RANK = 128
MLA_NOPE = 64
MLA_ROPE = 32
MLA_V = 64
MLA_QK = MLA_NOPE + MLA_ROPE
N_EXPERTS = 32
TOP_K = 4
D_EXPERT = 1024
SWIGLU_LIMIT = 7.0
SWIGLU_ALPHA = 1.702
ROPE_THETA = 10000.0
EPS = 1e-6
NEG_INF = -1e30
Q_BLOCK = 128
N_ADA = 6

NA_W = NA_HEADS * HEAD_DIM
GQA_QW = GQA_Q_HEADS * HEAD_DIM
GQA_KVW = GQA_KV_HEADS * HEAD_DIM
DN_W = DN_HEADS * HEAD_DIM
MLA_W = MLA_HEADS * MLA_V
MIX_W = NA_W + GQA_QW + DN_W + MLA_W
IN_SIZES = (NA_W, NA_W, NA_W, GQA_QW, GQA_KVW, GQA_KVW, DN_W, DN_W, DN_W, DN_W, 2 * DN_HEADS, 2 * DN_HEADS, MLA_Q_RANK, MLA_KV_RANK, MLA_ROPE)
IN_OFFSETS = tuple(int(o) for o in np.cumsum(IN_SIZES)[:-1])
IN_W = int(sum(IN_SIZES))

kernel_name = 'hybrid_natten_gqa_gdn_mla_moe_dit'


def rms_norm(x, g):
    xf = x.astype(jnp.float32)
    y = xf * lax.rsqrt(jnp.mean(jnp.square(xf), axis=-1, keepdims=True) + EPS)
    return (y * g.astype(jnp.float32)).astype(x.dtype)


def l2_norm(x):
    xf = x.astype(jnp.float32)
    return (xf * lax.rsqrt(jnp.sum(jnp.square(xf), axis=-1, keepdims=True) + EPS)).astype(x.dtype)


def modulate(h, shift, scale):
    return h * (1 + scale) + shift


def split_heads(t, n):
    return t.reshape(t.shape[0], t.shape[1], n, t.shape[2] // n)


def axial_rope_tables(n_tok, rot_dim):
    t = jnp.arange(n_tok, dtype=jnp.int32)
    row = (t // GRID_W).astype(jnp.float32)
    col = (t % GRID_W).astype(jnp.float32)
    n_freq = rot_dim // 4
    freqs = ROPE_THETA ** (-jnp.arange(n_freq, dtype=jnp.float32) / n_freq)
    ang = jnp.concatenate([row[:, None] * freqs, col[:, None] * freqs], axis=-1)
    return jnp.cos(ang), jnp.sin(ang)


def apply_rope(x, cos, sin):
    xf = x.astype(jnp.float32).reshape(*x.shape[:-1], -1, 2)
    x1, x2 = xf[..., 0], xf[..., 1]
    cs, sn = cos[:, None, :], sin[:, None, :]
    out = jnp.stack([x1 * cs - x2 * sn, x1 * sn + x2 * cs], axis=-1)
    return out.reshape(x.shape).astype(x.dtype)


def rope_tail(t, cos, sin):
    return jnp.concatenate([t[..., :MLA_NOPE], apply_rope(t[..., MLA_NOPE:], cos, sin)], axis=-1)


def blocked_attention(q, k, v):
    B, N, G, R, dk = q.shape
    nb = N // Q_BLOCK
    scale = dk ** -0.5
    qb = jnp.moveaxis(q.reshape(B, nb, Q_BLOCK, G, R, dk), 1, 0)

    def one_block(qi):
        s = jnp.einsum('bqgrd,bkgd->bgrqk', qi, k).astype(jnp.float32) * scale
        p = jax.nn.softmax(s, axis=-1).astype(v.dtype)
        return jnp.einsum('bgrqk,bkge->bqgre', p, v)

    o = lax.map(one_block, qb)
    return jnp.moveaxis(o, 0, 1).reshape(B, N, G, R, v.shape[-1])


def neighbourhood_attention(q, k, v, kc, vc, rel_bias):
    B, N, H, d = q.shape
    rows = N // GRID_W
    kr = min(NA_WIN_R, rows)
    scale = d ** -0.5
    qg = q.reshape(B, rows, GRID_W, H, d)
    kg = k.reshape(B, rows, GRID_W, H, d)
    vg = v.reshape(B, rows, GRID_W, H, d)
    r = jnp.arange(rows)
    r0 = jnp.clip(r - kr // 2, 0, rows - kr)
    ridx = r0[:, None] + jnp.arange(kr)[None, :]
    kw = kg[:, ridx]
    vw = vg[:, ridx]
    cpos = jnp.arange(GRID_W)
    c0 = jnp.clip(cpos - NA_WIN_C // 2, 0, GRID_W - NA_WIN_C)
    col_ok = (cpos[None, :] >= c0[:, None]) & (cpos[None, :] < c0[:, None] + NA_WIN_C)
    dr = ridx - r[:, None] + (NA_WIN_R - 1)
    dc = jnp.clip(cpos[None, :] - cpos[:, None], -(NA_WIN_C - 1), NA_WIN_C - 1) + (NA_WIN_C - 1)
    bias = rel_bias[:, dr[:, None, :, None], dc[None, :, None, :]]
    s_loc = jnp.einsum('brchd,brkwhd->bhrckw', qg, kw).astype(jnp.float32) * scale + bias.astype(jnp.float32)
    s_loc = jnp.where(col_ok[:, None, :], s_loc, NEG_INF)
    s_ctx = jnp.einsum('brchd,blhd->bhrcl', qg, kc).astype(jnp.float32) * scale
    s = jnp.concatenate([s_loc.reshape(B, H, rows, GRID_W, kr * GRID_W), s_ctx], axis=-1)
    p = jax.nn.softmax(s, axis=-1).astype(v.dtype)
    p_loc = p[..., :kr * GRID_W].reshape(B, H, rows, GRID_W, kr, GRID_W)
    p_ctx = p[..., kr * GRID_W:]
    o = jnp.einsum('bhrckw,brkwhd->brchd', p_loc, vw) + jnp.einsum('bhrcl,blhd->brchd', p_ctx, vc)
    return o.reshape(B, N, H, d)


def short_conv(x, w):
    C = x.shape[-1]
    return lax.conv_general_dilated(x, w[:, None, :].astype(x.dtype), window_strides=(1,),
                                    padding=[(DN_CONV // 2, DN_CONV // 2)],
                                    dimension_numbers=('NWC', 'WIO', 'NWC'), feature_group_count=C)


def dn_inputs(q, k, v, beta_raw, a_raw, conv_w, a_log, dt_bias):
    B, N, _ = q.shape
    qkv = jax.nn.silu(short_conv(jnp.concatenate([q, k, v], axis=-1), conv_w))
    q, k, v = [split_heads(t, DN_HEADS) for t in jnp.split(qkv, 3, axis=-1)]
    beta = jax.nn.sigmoid(beta_raw.astype(jnp.float32)).reshape(B, N, 2, DN_HEADS)
    g = -jnp.exp(a_log.astype(jnp.float32)) * jax.nn.softplus(
        a_raw.astype(jnp.float32).reshape(B, N, 2, DN_HEADS) + dt_bias.astype(jnp.float32))
    return l2_norm(q), l2_norm(k), v, g, beta


def gated_delta_chunked(q, k, v, g, beta, s0):
    B, N, H, dk = q.shape
    dv = v.shape[-1]
    nc = N // DN_CHUNK

    def chunks(t):
        t = t.astype(jnp.float32).reshape(B, nc, DN_CHUNK, H, *t.shape[3:])
        return jnp.moveaxis(jnp.moveaxis(t, 1, 0), 3, 2)

    qch = chunks(q) * dk ** -0.5
    kch = chunks(k)
    vch = chunks(v)
    gc = jnp.cumsum(chunks(g), axis=-1)
    bch = chunks(beta)
    i = jnp.arange(DN_CHUNK)
    lower = i[:, None] >= i[None, :]
    strict = i[:, None] > i[None, :]
    decay = jnp.exp(jnp.where(lower, gc[..., :, None] - gc[..., None, :], NEG_INF))
    kb = kch * bch[..., None]
    a = jnp.where(strict, jnp.einsum('nbhid,nbhjd->nbhij', kb, kch) * decay, 0.0)
    eye = jnp.eye(DN_CHUNK, dtype=jnp.float32)
    t_inv = lax.linalg.triangular_solve(eye + a, jnp.broadcast_to(eye, a.shape), left_side=True,
                                        lower=True, unit_diagonal=True)
    u = jnp.einsum('nbhij,nbhje->nbhie', t_inv, vch * bch[..., None])
    w = jnp.einsum('nbhij,nbhjd->nbhid', t_inv, kb * jnp.exp(gc)[..., None])
    attn = jnp.where(lower, jnp.einsum('nbhid,nbhjd->nbhij', qch, kch) * decay, 0.0)

    def step(S, inp):
        qi, ki, ui, wi, gi, ai = inp
        v_new = ui - jnp.einsum('bhcd,bhde->bhce', wi, S)
        o = jnp.einsum('bhcd,bhde->bhce', qi * jnp.exp(gi)[..., None], S) + jnp.einsum('bhij,bhje->bhie', ai, v_new)
        g_last = gi[..., -1]
        k_dec = ki * jnp.exp(g_last[..., None] - gi)[..., None]
        S = S * jnp.exp(g_last)[..., None, None] + jnp.einsum('bhcd,bhce->bhde', k_dec, v_new)
        return S, o

    s_final, o = lax.scan(step, s0.astype(jnp.float32), (qch, kch, u, w, gc, attn))
    o = jnp.moveaxis(jnp.moveaxis(o, 2, 3), 0, 1).reshape(B, N, H, dv)
    return o.astype(v.dtype), s_final


def bidir_scan(q, k, v, g, beta, s0_f, s0_b):
    o_f, s_f = gated_delta_chunked(q, k, v, g[:, :, 0], beta[:, :, 0], s0_f)
    o_b, s_b = gated_delta_chunked(jnp.flip(q, 1), jnp.flip(k, 1), jnp.flip(v, 1),
                                   jnp.flip(g[:, :, 1], 1), jnp.flip(beta[:, :, 1], 1), s0_b)
    return o_f + jnp.flip(o_b, 1), s_f, s_b


def mla_queries(cq, cq_g, w_uq, qn_g):
    B, N, _ = cq.shape
    q = (rms_norm(cq, cq_g) @ w_uq).reshape(B, N, MLA_HEADS, MLA_QK)
    return rms_norm(q, qn_g)


def mla_keys_values(ckv, kpe, ckv_g, w_ukv, kn_g):
    B, N, _ = ckv.shape
    kv = (rms_norm(ckv, ckv_g) @ w_ukv).reshape(B, N, MLA_HEADS, MLA_NOPE + MLA_V)
    k_pe = jnp.broadcast_to(kpe[:, :, None, :], (B, N, MLA_HEADS, MLA_ROPE))
    k = jnp.concatenate([kv[..., :MLA_NOPE], k_pe], axis=-1)
    return rms_norm(k, kn_g), kv[..., MLA_NOPE:]


def moe_ffn(t, router_w, router_b, w1, b1, w2, b2):
    logits = (t @ router_w + router_b).astype(jnp.float32)
    top_val, top_idx = lax.top_k(logits, TOP_K)
    gates = jax.nn.softmax(top_val, axis=-1)
    combine = jnp.sum(jax.nn.one_hot(top_idx, N_EXPERTS, dtype=jnp.float32) * gates[..., None], axis=1).astype(t.dtype)
    out = jnp.zeros_like(t)
    for e in range(N_EXPERTS):
        hh = t @ w1[e] + b1[e]
        glu = jnp.minimum(hh[:, :D_EXPERT], SWIGLU_LIMIT)
        lin = jnp.clip(hh[:, D_EXPERT:], -SWIGLU_LIMIT, SWIGLU_LIMIT)
        act = glu * jax.nn.sigmoid(SWIGLU_ALPHA * glu) * (lin + 1)
        out = out + combine[:, e:e + 1] * (act @ w2[e] + b2[e])
    return out


def setup_inputs(seed: int = 0) -> dict:
    key = jax.random.key(seed)
    ks = jax.random.split(key, 40)
    f32 = jnp.float32
    D = D_MODEL

    def nrm(k, shape, s):
        return jax.random.normal(k, shape, f32) * s

    dt = jnp.exp(jax.random.uniform(ks[17], (DEPTH, 2, DN_HEADS), f32, math.log(1e-3), math.log(1e-1)))
    return {
        'x': nrm(ks[0], (BATCH, SEQ, D), 1.0),
        'c': nrm(ks[1], (BATCH, D), 1.0),
        'ctx': nrm(ks[2], (BATCH, CTX_LEN, D), 1.0),
        'c_ctx': nrm(ks[3], (D,), 1.0),
        'ada_w': nrm(ks[4], (DEPTH, D, N_ADA * D), 0.5 * D ** -0.5),
        'ada_b': nrm(ks[5], (DEPTH, N_ADA * D), 0.02),
        'norm1_g': 1.0 + nrm(ks[6], (DEPTH, D), 0.02),
        'norm2_g': 1.0 + nrm(ks[7], (DEPTH, D), 0.02),
        'w_in': nrm(ks[8], (DEPTH, D, IN_W), D ** -0.5),
        'w_out': nrm(ks[9], (DEPTH, MIX_W, D), MIX_W ** -0.5),
        'na_qn_g': 1.0 + nrm(ks[10], (DEPTH, HEAD_DIM), 0.02),
        'na_kn_g': 1.0 + nrm(ks[11], (DEPTH, HEAD_DIM), 0.02),
        'na_rel_bias': nrm(ks[12], (DEPTH, NA_HEADS, 2 * NA_WIN_R - 1, 2 * NA_WIN_C - 1), 0.1),
        'gqa_qn_g': 1.0 + nrm(ks[13], (DEPTH, HEAD_DIM), 0.02),
        'gqa_kn_g': 1.0 + nrm(ks[14], (DEPTH, HEAD_DIM), 0.02),
        'dn_conv_w': nrm(ks[15], (DEPTH, DN_CONV, 3 * DN_W), DN_CONV ** -0.5),
        'dn_a_log': jnp.log(jax.random.uniform(ks[16], (DEPTH, 2, DN_HEADS), f32, 1.0, 16.0)),
        'dn_dt_bias': dt + jnp.log(-jnp.expm1(-dt)),
        'dn_out_g': 1.0 + nrm(ks[18], (DEPTH, HEAD_DIM), 0.02),
        'mla_cq_g': 1.0 + nrm(ks[19], (DEPTH, MLA_Q_RANK), 0.02),
        'mla_ckv_g': 1.0 + nrm(ks[20], (DEPTH, MLA_KV_RANK), 0.02),
        'mla_w_uq': nrm(ks[21], (DEPTH, MLA_Q_RANK, MLA_HEADS * MLA_QK), MLA_Q_RANK ** -0.5),
        'mla_w_ukv': nrm(ks[22], (DEPTH, MLA_KV_RANK, MLA_HEADS * (MLA_NOPE + MLA_V)), MLA_KV_RANK ** -0.5),
        'mla_qn_g': 1.0 + nrm(ks[23], (DEPTH, MLA_QK), 0.02),
        'mla_kn_g': 1.0 + nrm(ks[24], (DEPTH, MLA_QK), 0.02),
        'router_w': nrm(ks[25], (DEPTH, D, N_EXPERTS), D ** -0.5),
        'router_b': nrm(ks[26], (DEPTH, N_EXPERTS), 0.01),
        'exp_w1': nrm(ks[27], (DEPTH, N_EXPERTS, D, 2 * D_EXPERT), D ** -0.5),
        'exp_b1': nrm(ks[28], (DEPTH, N_EXPERTS, 2 * D_EXPERT), 0.01),
        'exp_w2': nrm(ks[29], (DEPTH, N_EXPERTS, D_EXPERT, D), D_EXPERT ** -0.5),
        'exp_b2': nrm(ks[30], (DEPTH, N_EXPERTS, D), 0.01),
    }


def reference(x, c, ctx, c_ctx, ada_w, ada_b, norm1_g, norm2_g, w_in, w_out, na_qn_g, na_kn_g, na_rel_bias,
              gqa_qn_g, gqa_kn_g, dn_conv_w, dn_a_log, dn_dt_bias, dn_out_g, mla_cq_g, mla_ckv_g, mla_w_uq,
              mla_w_ukv, mla_qn_g, mla_kn_g, router_w, router_b, exp_w1, exp_b1, exp_w2, exp_b2):
    B, N, D = x.shape
    L = ctx.shape[1]
    grp = GQA_Q_HEADS // GQA_KV_HEADS
    cos_g, sin_g = axial_rope_tables(N, HEAD_DIM)
    cos_m, sin_m = axial_rope_tables(N, MLA_ROPE)
    sc = jax.nn.silu(c)
    scc = jax.nn.silu(c_ctx)
    s0 = jnp.zeros((B, DN_HEADS, HEAD_DIM, HEAD_DIM), jnp.float32)
    for l in range(DEPTH):
        with_ctx = l < DEPTH - 1
        mod = jnp.split(sc @ ada_w[l] + ada_b[l], N_ADA, axis=-1)
        mod_c = jnp.split(scc @ ada_w[l] + ada_b[l], N_ADA, axis=-1)
        h = modulate(rms_norm(x, norm1_g[l]), mod[0][:, None], mod[1][:, None])
        hc = modulate(rms_norm(ctx, norm1_g[l]), mod_c[0], mod_c[1])
        p = jnp.split(h @ w_in[l], IN_OFFSETS, axis=-1)
        pc = jnp.split(hc @ w_in[l], IN_OFFSETS, axis=-1)

        qa = rms_norm(split_heads(p[0], NA_HEADS), na_qn_g[l])
        ka = rms_norm(split_heads(p[1], NA_HEADS), na_kn_g[l])
        va = split_heads(p[2], NA_HEADS)
        kac = rms_norm(split_heads(pc[1], NA_HEADS), na_kn_g[l])
        vac = split_heads(pc[2], NA_HEADS)
        ya = neighbourhood_attention(qa, ka, va, kac, vac, na_rel_bias[l]).reshape(B, N, NA_W)

        qb = apply_rope(rms_norm(split_heads(p[3], GQA_Q_HEADS), gqa_qn_g[l]), cos_g, sin_g)
        kb = apply_rope(rms_norm(split_heads(p[4], GQA_KV_HEADS), gqa_kn_g[l]), cos_g, sin_g)
        vb = split_heads(p[5], GQA_KV_HEADS)
        kbc = rms_norm(split_heads(pc[4], GQA_KV_HEADS), gqa_kn_g[l])
        vbc = split_heads(pc[5], GQA_KV_HEADS)
        yb = blocked_attention(qb.reshape(B, N, GQA_KV_HEADS, grp, HEAD_DIM),
                               jnp.concatenate([kb, kbc], axis=1), jnp.concatenate([vb, vbc], axis=1)).reshape(B, N, GQA_QW)

        qdc, kdc, vdc, gdc, bdc = dn_inputs(pc[6], pc[7], pc[8], pc[10], pc[11], dn_conv_w[l], dn_a_log[l], dn_dt_bias[l])
        odc, s_f, s_b = bidir_scan(qdc, kdc, vdc, gdc, bdc, s0, s0)
        qd, kd, vd, gd, bd = dn_inputs(p[6], p[7], p[8], p[10], p[11], dn_conv_w[l], dn_a_log[l], dn_dt_bias[l])
        od, _, _ = bidir_scan(qd, kd, vd, gd, bd, s_f, s_b)
        yc = (rms_norm(od, dn_out_g[l]) * jax.nn.silu(split_heads(p[9], DN_HEADS))).reshape(B, N, DN_W)

        qm = rope_tail(mla_queries(p[12], mla_cq_g[l], mla_w_uq[l], mla_qn_g[l]), cos_m, sin_m)
        km, vm = mla_keys_values(p[13], p[14], mla_ckv_g[l], mla_w_ukv[l], mla_kn_g[l])
        km = rope_tail(km, cos_m, sin_m)
        kmc, vmc = mla_keys_values(pc[13], pc[14], mla_ckv_g[l], mla_w_ukv[l], mla_kn_g[l])
        yd = blocked_attention(qm[:, :, :, None], jnp.concatenate([km, kmc], axis=1),
                               jnp.concatenate([vm, vmc], axis=1)).reshape(B, N, MLA_W)

        x = x + mod[2][:, None] * (jnp.concatenate([ya, yb, yc, yd], axis=-1) @ w_out[l])
        h2 = modulate(rms_norm(x, norm2_g[l]), mod[3][:, None], mod[4][:, None])

        if with_ctx:
            qac = rms_norm(split_heads(pc[0], NA_HEADS), na_qn_g[l])
            yac = blocked_attention(qac[:, :, :, None], kac, vac).reshape(B, L, NA_W)
            qbc = rms_norm(split_heads(pc[3], GQA_Q_HEADS), gqa_qn_g[l])
            ybc = blocked_attention(qbc.reshape(B, L, GQA_KV_HEADS, grp, HEAD_DIM), kbc, vbc).reshape(B, L, GQA_QW)
            ycc = (rms_norm(odc, dn_out_g[l]) * jax.nn.silu(split_heads(pc[9], DN_HEADS))).reshape(B, L, DN_W)
            qmc = mla_queries(pc[12], mla_cq_g[l], mla_w_uq[l], mla_qn_g[l])
            ydc = blocked_attention(qmc[:, :, :, None], kmc, vmc).reshape(B, L, MLA_W)
            ctx = ctx + mod_c[2] * (jnp.concatenate([yac, ybc, ycc, ydc], axis=-1) @ w_out[l])
            h2c = modulate(rms_norm(ctx, norm2_g[l]), mod_c[3], mod_c[4])
            tok = jnp.concatenate([h2.reshape(B * N, D), h2c.reshape(B * L, D)], axis=0)
            f = moe_ffn(tok, router_w[l], router_b[l], exp_w1[l], exp_b1[l], exp_w2[l], exp_b2[l])
            x = x + mod[5][:, None] * f[:B * N].reshape(B, N, D)
            ctx = ctx + mod_c[5] * f[B * N:].reshape(B, L, D)
        else:
            f = moe_ffn(h2.reshape(B * N, D), router_w[l], router_b[l], exp_w1[l], exp_b1[l], exp_w2[l], exp_b2[l])
            x = x + mod[5][:, None] * f.reshape(B, N, D)
    return x
```

```cpp
#include <hip/hip_runtime.h>
#include <cstdint>
#include <cstdio>

#ifndef N_LAUNCH_MODE
#define N_LAUNCH_MODE 0
#endif

namespace {
typedef unsigned short bf16_t;
typedef short bf16x8 __attribute__((ext_vector_type(8)));
typedef float f32x4 __attribute__((ext_vector_type(4)));
typedef float f32x16 __attribute__((ext_vector_type(16)));
typedef unsigned u32x2 __attribute__((ext_vector_type(2)));
typedef unsigned u32x4 __attribute__((ext_vector_type(4)));

constexpr int D = 1024, NB = 8, SEQ = 4096, CTX = 256, GW = 64;
constexpr int NLAT = NB * SEQ, NCTX = NB * CTX, MROWS = NLAT + NCTX;
constexpr int KV = SEQ + CTX;
constexpr int INW = 2736, INWP = 2816;
constexpr int O_NAQ = 0, O_NAK = 256, O_NAV = 512, O_GQ = 768, O_GK = 1024, O_GV = 1152, O_DQ = 1280, O_DK = 1536, O_DV = 1792,
              O_DG = 2048, O_DB = 2304, O_DA = 2312, O_CQ = 2320, O_CKV = 2576, O_KPE = 2704;
constexpr int NEXP = 32, DEXP = 1024, TOPK = 4;
constexpr int NCH = KV / 64;
constexpr float EPS = 1e-6f, LOG2E = 1.4426950408889634f;
constexpr int NTHREADS = 512;

enum { I_X, I_C, I_CTX, I_CCTX, I_ADAW, I_ADAB, I_N1G, I_N2G, I_WIN, I_WOUT, I_NAQG, I_NAKG, I_NABIAS, I_GQG, I_GKG, I_DCONV, I_DALOG, I_DDT, I_DOUTG,
       I_MCQG, I_MCKVG, I_MWUQ, I_MWUKV, I_MQNG, I_MKNG, I_RW, I_RB, I_W1, I_B1, I_W2, I_B2, N_IN };

constexpr size_t al(size_t x) { return (x + 4095) & ~(size_t)4095; }
constexpr size_t WS_CTL = 0, CTL_BYTES = 1u << 20;
constexpr size_t WS_MODS = WS_CTL + CTL_BYTES;
constexpr size_t WS_TRG = al(WS_MODS + 2 * 9 * 6144 * 4);
constexpr size_t WS_TRM = al(WS_TRG + 4096 * 32 * 2 * 4);
constexpr size_t WS_WIN = al(WS_TRM + 4096 * 16 * 2 * 4);
constexpr size_t WS_WOUT = al(WS_WIN + (size_t)2 * INWP * D * 2);
constexpr size_t WS_WUQ = al(WS_WOUT + (size_t)2 * D * D * 2);
constexpr size_t WS_WUKV = al(WS_WUQ + 2 * 384 * 256 * 2);
constexpr size_t WS_W1 = al(WS_WUKV + 2 * 512 * 128 * 2);
constexpr size_t WS_W2 = al(WS_W1 + (size_t)2 * NEXP * 2048 * D * 2);
constexpr size_t WS_XCUR = al(WS_W2 + (size_t)2 * NEXP * D * D * 2);
constexpr size_t WS_HB = al(WS_XCUR + (size_t)MROWS * D * 4);
constexpr size_t WS_LIST = al(WS_HB + (size_t)MROWS * D * 2);
constexpr size_t WS_GATE = al(WS_LIST + (size_t)NEXP * MROWS * 4);
constexpr size_t WS_OVL = al(WS_GATE + (size_t)MROWS * 4 * 4);
constexpr size_t WS_P = WS_OVL;
constexpr size_t WS_G16 = al(WS_P + (size_t)MROWS * INWP * 2);
constexpr size_t HB64 = (size_t)NB * KV * 64 * 2;
constexpr size_t WS_QNA = al(WS_G16 + (size_t)MROWS * 16 * 4);
constexpr size_t WS_KNA = al(WS_QNA + 4 * HB64);
constexpr size_t WS_VTNA = al(WS_KNA + 4 * HB64);
constexpr size_t WS_QG = al(WS_VTNA + 4 * HB64);
constexpr size_t WS_KG = al(WS_QG + 4 * HB64);
constexpr size_t WS_VTG = al(WS_KG + 2 * HB64);
constexpr size_t WS_UQ = al(WS_VTG + 2 * HB64);
constexpr size_t WS_UKV = al(WS_UQ + (size_t)MROWS * 384 * 2);
constexpr size_t WS_QM = al(WS_UKV + (size_t)MROWS * 512 * 2);
constexpr size_t WS_KM = al(WS_QM + (size_t)NB * 4 * KV * 96 * 2);
constexpr size_t WS_VTM = al(WS_KM + (size_t)NB * 4 * KV * 96 * 2);
constexpr size_t WS_QD = al(WS_VTM + 4 * HB64);
constexpr size_t WS_KD = al(WS_QD + 4 * HB64);
constexpr size_t WS_VD = al(WS_KD + 4 * HB64);
constexpr size_t WS_DG = al(WS_VD + 4 * HB64);
constexpr size_t WS_DBETA = al(WS_DG + (size_t)NB * 4 * 2 * KV * 4);
constexpr size_t DNMAT = (size_t)NB * 4 * 2 * NCH * 4096 * 4;
constexpr size_t WS_DU = al(WS_DBETA + (size_t)NB * 4 * 2 * KV * 4);
constexpr size_t WS_DW = al(WS_DU + DNMAT);
constexpr size_t WS_DM = al(WS_DW + DNMAT);
constexpr size_t WS_DN = al(WS_DM + DNMAT);
constexpr size_t WS_DS = al(WS_DN + DNMAT);
constexpr size_t WS_Y = al(WS_DS + DNMAT);
constexpr size_t WS_END1 = al(WS_Y + (size_t)MROWS * D * 2);
constexpr int HROWS_MAX = MROWS * TOPK + NEXP * 128;
constexpr size_t WS_H = WS_OVL;
constexpr size_t WS_YEXP = al(WS_H + (size_t)HROWS_MAX * DEXP * 2);
constexpr size_t WS_END2 = al(WS_YEXP + (size_t)MROWS * TOPK * D * 2);
constexpr size_t WS_TOTAL = WS_END1 > WS_END2 ? WS_END1 : WS_END2;
static_assert(WS_TOTAL < (size_t)2100 * 1000 * 1000, "workspace map exceeds the guaranteed 4 x largest tensor");

constexpr int CW_BAR = 0;
constexpr int CW_CNT = 4096;
constexpr int CW_ERR = 8192;

constexpr int LDS_BYTES = 147456;

struct Params { const float* in[N_IN]; float* out; unsigned char* ws; int ph_lo, ph_hi; };

#define DEVI __device__ __forceinline__
DEVI float bf2f(bf16_t x) { return __builtin_bit_cast(float, (unsigned)x << 16); }
DEVI bf16_t f2bf(float f) { unsigned u = __builtin_bit_cast(unsigned, f); return (bf16_t)((u + 0x7fffu + ((u >> 16) & 1u)) >> 16); }
DEVI unsigned pk2(float lo, float hi) { return (unsigned)f2bf(lo) | ((unsigned)f2bf(hi) << 16); }
DEVI float wave_sum(float v) {
#pragma unroll
    for (int o = 32; o > 0; o >>= 1) v += __shfl_xor(v, o);
    return v;
}
DEVI float siluf(float y) { return y / (1.f + __expf(-y)); }
DEVI float sigmoidf(float y) { return 1.f / (1.f + __expf(-y)); }
DEVI void row2bp(int row, int& b, int& pos) { if (row < NLAT) { b = row >> 12; pos = row & 4095; } else { const int r = row - NLAT; b = r >> 8; pos = SEQ + (r & 255); } }
DEVI int bp2row(int b, int pos) { return pos < SEQ ? b * SEQ + pos : NLAT + b * CTX + (pos - SEQ); }

template <class T> DEVI T* wsp(const Params& p, size_t off) { return (T*)(p.ws + off); }

DEVI void tr_tile(const float* src, int ld, int k0, int n0, int nvalid, const float* rs, bf16_t* dst, int K, int perm, float* tile) {
    const int tid = threadIdx.x;
    { const int kk = tid >> 3, c8 = (tid & 7) * 8; float v[8];
      if (n0 + c8 < nvalid) { const float* s = src + (size_t)(k0 + kk) * ld + n0 + c8; const f32x4 a = *(const f32x4*)s, b = *(const f32x4*)(s + 4);
          v[0] = a[0]; v[1] = a[1]; v[2] = a[2]; v[3] = a[3]; v[4] = b[0]; v[5] = b[1]; v[6] = b[2]; v[7] = b[3]; }
      else {
#pragma unroll
          for (int j = 0; j < 8; ++j) v[j] = 0.f; }
      const float sc = rs ? rs[k0 + kk] : 1.f;
#pragma unroll
      for (int j = 0; j < 8; ++j) tile[kk * 65 + c8 + j] = v[j] * sc; }
    __syncthreads();
    { const int nn = tid >> 3, k8 = (tid & 7) * 8; u32x4 w;
      w.x = pk2(tile[(k8 + 0) * 65 + nn], tile[(k8 + 1) * 65 + nn]); w.y = pk2(tile[(k8 + 2) * 65 + nn], tile[(k8 + 3) * 65 + nn]);
      w.z = pk2(tile[(k8 + 4) * 65 + nn], tile[(k8 + 5) * 65 + nn]); w.w = pk2(tile[(k8 + 6) * 65 + nn], tile[(k8 + 7) * 65 + nn]);
      const int n = n0 + nn; int drow = n;
      if (perm) { const int j = n & 1023, hi = n >> 10; drow = (j >> 4) * 32 + hi * 16 + (j & 15); }
      *(u32x4*)(dst + (size_t)drow * K + k0 + k8) = w; }
    __syncthreads();
}

DEVI void ph_prologue(const Params& p, char* lds) {
    const int tid = threadIdx.x, lane = tid & 63, wid = tid >> 6;
    if (blockIdx.x < 192) {
        float* sv = (float*)lds;
        float* red = (float*)(lds + 36864);
        for (int i = tid; i < 9 * 1024; i += NTHREADS) { const int r = i >> 10, k = i & 1023; const float c = r < 8 ? p.in[I_C][r * 1024 + k] : p.in[I_CCTX][k]; sv[i] = siluf(c); }
        __syncthreads();
        for (int it = blockIdx.x; it < 192; it += gridDim.x) {
            const int l = it / 96, cg = it % 96;
            const float* W = p.in[I_ADAW] + (size_t)l * D * 6144 + cg * 64 + lane;
            float acc[9];
#pragma unroll
            for (int r = 0; r < 9; ++r) acc[r] = 0.f;
            for (int k = wid * 128; k < wid * 128 + 128; ++k) { const float w = W[(size_t)k * 6144];
#pragma unroll
                for (int r = 0; r < 9; ++r) acc[r] += sv[r * 1024 + k] * w; }
#pragma unroll
            for (int r = 0; r < 9; ++r) red[(wid * 9 + r) * 64 + lane] = acc[r];
            __syncthreads();
            for (int i = tid; i < 576; i += NTHREADS) { const int r = i >> 6, c = i & 63; float s = 0.f;
#pragma unroll
                for (int w = 0; w < 8; ++w) s += red[(w * 9 + r) * 64 + c];
                wsp<float>(p, WS_MODS)[(size_t)(l * 9 + r) * 6144 + cg * 64 + c] = s + p.in[I_ADAB][l * 6144 + cg * 64 + c]; }
            __syncthreads();
        }
    }
    for (int i = blockIdx.x * NTHREADS + tid; i < 4096 * 48; i += gridDim.x * NTHREADS) {
        const int t = i / 48, q = i % 48; const float row = (float)(t / GW), col = (float)(t % GW);
        if (q < 32) { const int f = q & 15; const float fr = powf(10000.f, -(float)f / 16.f); const float a = (q < 16 ? row : col) * fr; float s, c; sincosf(a, &s, &c);
            float* o = wsp<float>(p, WS_TRG) + ((size_t)t * 32 + q) * 2; o[0] = c; o[1] = s; }
        else { const int qq = q - 32, f = qq & 7; const float fr = powf(10000.f, -(float)f / 8.f); const float a = (qq < 8 ? row : col) * fr; float s, c; sincosf(a, &s, &c);
            float* o = wsp<float>(p, WS_TRM) + ((size_t)t * 16 + qq) * 2; o[0] = c; o[1] = s; }
    }
    float* tile = (float*)lds;
    constexpr int T_W1 = 64 * 512, T_W2 = 64 * 256, T_WIN = 2 * 16 * 44, T_WOUT = 2 * 256, T_WUQ = 2 * 4 * 6, T_WUKV = 2 * 2 * 8;
    constexpr int T_ALL = T_W1 + T_W2 + T_WIN + T_WOUT + T_WUQ + T_WUKV;
    for (int it = blockIdx.x; it < T_ALL; it += gridDim.x) {
        int i = it;
        if (i < T_W1) { const int le = i >> 9, t = i & 511, kt = t >> 5, nt = t & 31;
            tr_tile(p.in[I_W1] + (size_t)le * D * 2048, 2048, kt * 64, nt * 64, 2048, nullptr, wsp<bf16_t>(p, WS_W1) + (size_t)le * 2048 * D, D, 1, tile); continue; }
        i -= T_W1;
        if (i < T_W2) { const int le = i >> 8, t = i & 255, kt = t >> 4, nt = t & 15;
            tr_tile(p.in[I_W2] + (size_t)le * DEXP * D, D, kt * 64, nt * 64, D, nullptr, wsp<bf16_t>(p, WS_W2) + (size_t)le * D * DEXP, DEXP, 0, tile); continue; }
        i -= T_W2;
        if (i < T_WIN) { const int l = i / 704, t = i % 704, kt = t / 44, nt = t % 44;
            tr_tile(p.in[I_WIN] + (size_t)l * D * INW, INW, kt * 64, nt * 64, INW, nullptr, wsp<bf16_t>(p, WS_WIN) + (size_t)l * INWP * D, D, 0, tile); continue; }
        i -= T_WIN;
        if (i < T_WOUT) { const int l = i >> 8, t = i & 255, kt = t >> 4, nt = t & 15;
            tr_tile(p.in[I_WOUT] + (size_t)l * D * D, D, kt * 64, nt * 64, D, nullptr, wsp<bf16_t>(p, WS_WOUT) + (size_t)l * D * D, D, 0, tile); continue; }
        i -= T_WOUT;
        if (i < T_WUQ) { const int l = i / 24, t = i % 24, kt = t / 6, nt = t % 6;
            tr_tile(p.in[I_MWUQ] + (size_t)l * 256 * 384, 384, kt * 64, nt * 64, 384, p.in[I_MCQG] + l * 256, wsp<bf16_t>(p, WS_WUQ) + (size_t)l * 384 * 256, 256, 0, tile); continue; }
        i -= T_WUQ;
        { const int l = i / 16, t = i % 16, kt = t / 8, nt = t % 8;
            tr_tile(p.in[I_MWUKV] + (size_t)l * 128 * 512, 512, kt * 64, nt * 64, 512, p.in[I_MCKVG] + l * 128, wsp<bf16_t>(p, WS_WUKV) + (size_t)l * 512 * 128, 128, 0, tile); }
    }
}

DEVI void norm_mod_row(const float* x, const float* g, const float* shift, const float* scale, bf16_t* out, int lane, float (*keep)[4] = nullptr) {
    f32x4 v[4]; float ss = 0.f;
#pragma unroll
    for (int i = 0; i < 4; ++i) { v[i] = *(const f32x4*)(x + i * 256 + lane * 4); ss += v[i][0] * v[i][0] + v[i][1] * v[i][1] + v[i][2] * v[i][2] + v[i][3] * v[i][3]; }
    ss = wave_sum(ss); const float r = rsqrtf(ss * (1.f / 1024.f) + EPS);
#pragma unroll
    for (int i = 0; i < 4; ++i) { const int c = i * 256 + lane * 4; const f32x4 gg = *(const f32x4*)(g + c), sh = *(const f32x4*)(shift + c), sc = *(const f32x4*)(scale + c);
        f32x4 y;
#pragma unroll
        for (int j = 0; j < 4; ++j) { y[j] = (v[i][j] * r * gg[j]) * (1.f + sc[j]) + sh[j]; if (keep) keep[i][j] = y[j]; }
        u32x2 w; w.x = pk2(y[0], y[1]); w.y = pk2(y[2], y[3]); *(u32x2*)(out + c) = w; }
}
DEVI const float* mod_vec(const Params& p, int l, int row, int which) {
    const int r = row < NLAT ? (row >> 12) : 8; return wsp<float>(p, WS_MODS) + (size_t)(l * 9 + r) * 6144 + which * 1024; }

DEVI void ph_norm1_l0(const Params& p) {
    const int lane = threadIdx.x & 63, gw = blockIdx.x * 8 + (threadIdx.x >> 6), nw = gridDim.x * 8;
    for (int row = gw; row < MROWS; row += nw) {
        const float* x = row < NLAT ? p.in[I_X] + (size_t)row * D : p.in[I_CTX] + (size_t)(row - NLAT) * D;
        norm_mod_row(x, p.in[I_N1G], mod_vec(p, 0, row, 0), mod_vec(p, 0, row, 1), wsp<bf16_t>(p, WS_HB) + (size_t)row * D, lane);
    }
}

struct GUnit { const bf16_t* A; size_t lda; const int* rows; int nvalid, rshift; const bf16_t* B; size_t ldb; int m0, n0, e, tr; };
constexpr int G_LDS = 2 * 128 * 72 * 2;
template <class Epi> DEVI void gemm_unit(char* lds, const GUnit& u, int K, const Epi& E) {
    const int tid = threadIdx.x, lane = tid & 63, wid = tid >> 6, wm = wid >> 1, wn = wid & 1;
    bf16_t* As = (bf16_t*)lds; bf16_t* Bs = As + 128 * 72;
    const int r0 = tid >> 3, ch = tid & 7;
    const bf16_t* ap[2]; const bf16_t* bp[2];
#pragma unroll
    for (int i = 0; i < 2; ++i) { const int r = r0 + 64 * i;
        size_t arow; if (u.rows) arow = (r < u.nvalid) ? (size_t)(u.rows[r] >> u.rshift) : 0; else arow = (size_t)(u.m0 + r);
        ap[i] = u.A + arow * u.lda + ch * 8; bp[i] = u.B + (size_t)(u.n0 + r) * u.ldb + ch * 8; }
    f32x4 acc[2][4];
#pragma unroll
    for (int a = 0; a < 2; ++a)
#pragma unroll
        for (int b = 0; b < 4; ++b) acc[a][b] = (f32x4){0.f, 0.f, 0.f, 0.f};
    u32x4 ra[2], rb[2];
#pragma unroll
    for (int i = 0; i < 2; ++i) { ra[i] = *(const u32x4*)ap[i]; rb[i] = *(const u32x4*)bp[i]; }
    const int nk = K / 64;
    for (int kt = 0; kt < nk; ++kt) {
        __syncthreads();
#pragma unroll
        for (int i = 0; i < 2; ++i) { *(u32x4*)(As + (r0 + 64 * i) * 72 + ch * 8) = ra[i]; *(u32x4*)(Bs + (r0 + 64 * i) * 72 + ch * 8) = rb[i]; }
        __syncthreads();
        if (kt + 1 < nk) {
#pragma unroll
            for (int i = 0; i < 2; ++i) { ra[i] = *(const u32x4*)(ap[i] + (kt + 1) * 64); rb[i] = *(const u32x4*)(bp[i] + (kt + 1) * 64); } }
#pragma unroll
        for (int ks = 0; ks < 2; ++ks) {
            bf16x8 af[2], bfr[4];
#pragma unroll
            for (int mt = 0; mt < 2; ++mt) af[mt] = *(const bf16x8*)(As + (wm * 32 + mt * 16 + (lane & 15)) * 72 + ks * 32 + 8 * (lane >> 4));
#pragma unroll
            for (int nt = 0; nt < 4; ++nt) bfr[nt] = *(const bf16x8*)(Bs + (wn * 64 + nt * 16 + (lane & 15)) * 72 + ks * 32 + 8 * (lane >> 4));
#pragma unroll
            for (int mt = 0; mt < 2; ++mt)
#pragma unroll
                for (int nt = 0; nt < 4; ++nt) acc[mt][nt] = __builtin_amdgcn_mfma_f32_16x16x32_bf16(bfr[nt], af[mt], acc[mt][nt], 0, 0, 0);
        }
    }
    E(acc, u, wm, wn, lane);
}

struct EpiP { bf16_t* P; float* G16;
    DEVI void operator()(const f32x4 (&acc)[2][4], const GUnit& u, int wm, int wn, int lane) const {
#pragma unroll
        for (int mt = 0; mt < 2; ++mt)
#pragma unroll
            for (int nt = 0; nt < 4; ++nt) { const int row = u.m0 + wm * 32 + mt * 16 + (lane & 15), col = u.n0 + wn * 64 + nt * 16 + 4 * (lane >> 4); const f32x4 v = acc[mt][nt];
                u32x2 w; w.x = pk2(v[0], v[1]); w.y = pk2(v[2], v[3]); *(u32x2*)(P + (size_t)row * INWP + col) = w;
                if (col >= O_DB && col < O_DB + 16) *(f32x4*)(G16 + (size_t)row * 16 + (col - O_DB)) = v; }
    } };
struct EpiBf { bf16_t* O; int ldo;
    DEVI void operator()(const f32x4 (&acc)[2][4], const GUnit& u, int wm, int wn, int lane) const {
#pragma unroll
        for (int mt = 0; mt < 2; ++mt)
#pragma unroll
            for (int nt = 0; nt < 4; ++nt) { const int row = u.m0 + wm * 32 + mt * 16 + (lane & 15), col = u.n0 + wn * 64 + nt * 16 + 4 * (lane >> 4); const f32x4 v = acc[mt][nt];
                u32x2 w; w.x = pk2(v[0], v[1]); w.y = pk2(v[2], v[3]); *(u32x2*)(O + (size_t)row * ldo + col) = w; }
    } };
struct EpiOut { const Params* p; int l;
    DEVI void operator()(const f32x4 (&acc)[2][4], const GUnit& u, int wm, int wn, int lane) const {
#pragma unroll
        for (int mt = 0; mt < 2; ++mt) { const int row = u.m0 + wm * 32 + mt * 16 + (lane & 15);
            const float* base = l == 0 ? (row < NLAT ? p->in[I_X] + (size_t)row * D : p->in[I_CTX] + (size_t)(row - NLAT) * D) : wsp<float>(*p, WS_XCUR) + (size_t)row * D;
            const float* g = mod_vec(*p, l, row, 2); float* o = wsp<float>(*p, WS_XCUR) + (size_t)row * D;
#pragma unroll
            for (int nt = 0; nt < 4; ++nt) { const int col = u.n0 + wn * 64 + nt * 16 + 4 * (lane >> 4); const f32x4 bs = *(const f32x4*)(base + col), gg = *(const f32x4*)(g + col);
                *(f32x4*)(o + col) = bs + gg * acc[mt][nt]; } }
    } };
struct EpiH { bf16_t* H; const float* b1;
    DEVI void operator()(const f32x4 (&acc)[2][4], const GUnit& u, int wm, int wn, int lane) const {
        const float* bb = b1 + (size_t)u.e * 2048;
#pragma unroll
        for (int mt = 0; mt < 2; ++mt) { const size_t hrow = (size_t)u.tr * 128 + wm * 32 + mt * 16 + (lane & 15);
#pragma unroll
            for (int g = 0; g < 2; ++g) { const int acol = (u.n0 >> 1) + wn * 32 + g * 16 + 4 * (lane >> 4);
                const f32x4 bg = *(const f32x4*)(bb + acol), bl = *(const f32x4*)(bb + 1024 + acol); f32x4 o;
#pragma unroll
                for (int j = 0; j < 4; ++j) { const float glu = fminf(acc[mt][2 * g][j] + bg[j], 7.f); const float lin = fminf(fmaxf(acc[mt][2 * g + 1][j] + bl[j], -7.f), 7.f);
                    o[j] = glu * sigmoidf(1.702f * glu) * (lin + 1.f); }
                u32x2 w; w.x = pk2(o[0], o[1]); w.y = pk2(o[2], o[3]); *(u32x2*)(H + hrow * DEXP + acol) = w; } }
    } };
struct EpiY { bf16_t* Y; const float* b2; const int* rows;
    DEVI void operator()(const f32x4 (&acc)[2][4], const GUnit& u, int wm, int wn, int lane) const {
        const float* bb = b2 + (size_t)u.e * D;
#pragma unroll
        for (int mt = 0; mt < 2; ++mt) { const int r = wm * 32 + mt * 16 + (lane & 15); if (r >= u.nvalid) continue; const size_t yrow = (size_t)rows[r];
#pragma unroll
            for (int nt = 0; nt < 4; ++nt) { const int col = u.n0 + wn * 64 + nt * 16 + 4 * (lane >> 4); const f32x4 v = acc[mt][nt] + *(const f32x4*)(bb + col);
                u32x2 w; w.x = pk2(v[0], v[1]); w.y = pk2(v[2], v[3]); *(u32x2*)(Y + yrow * D + col) = w; } }
    } };

template <class Epi> DEVI void gemm_dense(char* lds, const bf16_t* A, size_t lda, const bf16_t* B, size_t ldb, int Mrows, int Ncols, int K, const Epi& E) {
    const int nt = Ncols / 128, total = (Mrows / 128) * nt;
    for (int i = blockIdx.x; i < total; i += gridDim.x) { GUnit u; u.A = A; u.lda = lda; u.rows = nullptr; u.nvalid = 128; u.rshift = 0; u.B = B; u.ldb = ldb; u.m0 = (i / nt) * 128; u.n0 = (i % nt) * 128; u.e = 0; u.tr = 0;
        gemm_unit(lds, u, K, E); }
}

DEVI void ph_inproj(const Params& p, char* lds, int l) {
    EpiP E{wsp<bf16_t>(p, WS_P), wsp<float>(p, WS_G16)};
    gemm_dense(lds, wsp<bf16_t>(p, WS_HB), D, wsp<bf16_t>(p, WS_WIN) + (size_t)l * INWP * D, D, MROWS, INWP, D, E);
}
DEVI void ph_outproj(const Params& p, char* lds, int l) {
    EpiOut E{&p, l};
    gemm_dense(lds, wsp<bf16_t>(p, WS_Y), D, wsp<bf16_t>(p, WS_WOUT) + (size_t)l * D * D, D, l == 0 ? MROWS : NLAT, D, D, E);
}

DEVI void store_vt(bf16_t* sc, int lane, bf16_t* dstT  ) {
#pragma unroll
    for (int c = 0; c < 8; ++c) { u32x4 w; unsigned t[4];
#pragma unroll
        for (int j = 0; j < 4; ++j) t[j] = (unsigned)sc[(c * 8 + 2 * j) * 66 + lane] | ((unsigned)sc[(c * 8 + 2 * j + 1) * 66 + lane] << 16);
        w.x = t[0]; w.y = t[1]; w.z = t[2]; w.w = t[3]; *(u32x4*)(dstT + (size_t)lane * KV + c * 8) = w; }
}

DEVI void ph_post(const Params& p, char* lds, int l) {
    { EpiBf E{wsp<bf16_t>(p, WS_UQ), 384};
      gemm_dense(lds, wsp<bf16_t>(p, WS_P) + O_CQ, INWP, wsp<bf16_t>(p, WS_WUQ) + (size_t)l * 384 * 256, 256, MROWS, 384, 256, E); }
    { EpiBf E{wsp<bf16_t>(p, WS_UKV), 512};
      gemm_dense(lds, wsp<bf16_t>(p, WS_P) + O_CKV, INWP, wsp<bf16_t>(p, WS_WUKV) + (size_t)l * 512 * 128, 128, MROWS, 512, 128, E); }
    __syncthreads();
    const int tid = threadIdx.x, lane = tid & 63, wid = tid >> 6;
    bf16_t* sc = (bf16_t*)(lds + wid * 8448);
    const bf16_t* P = wsp<bf16_t>(p, WS_P);
    constexpr int NJOB = 33, NITEM = NB * NCH * NJOB;
    for (int it = blockIdx.x * 8 + wid; it < NITEM; it += gridDim.x * 8) {
        const int job = it % NJOB, bb = it / NJOB, b = bb / NCH, blk = bb % NCH, pos0 = blk * 64, row0 = bp2row(b, pos0);
        const bool lat = pos0 < SEQ;
        if (job < 8) {
            const int h = job & 3, isq = job < 4; const float g = p.in[isq ? I_NAQG : I_NAKG][l * 64 + lane] * (isq ? 0.125f * LOG2E : 1.f);
            bf16_t* dst = wsp<bf16_t>(p, isq ? WS_QNA : WS_KNA) + ((size_t)(b * 4 + h) * KV + pos0) * 64;
            for (int t = 0; t < 64; ++t) { const float v = bf2f(P[(size_t)(row0 + t) * INWP + (isq ? O_NAQ : O_NAK) + h * 64 + lane]);
                const float ss = wave_sum(v * v); dst[t * 64 + lane] = f2bf(v * rsqrtf(ss * (1.f / 64.f) + EPS) * g); }
        } else if (job < 12 || (job >= 18 && job < 20)) {
            const bool na = job < 12; const int h = na ? job - 8 : job - 18, off = na ? O_NAV : O_GV;
            for (int t = 0; t < 64; ++t) sc[t * 66 + lane] = P[(size_t)(row0 + t) * INWP + off + h * 64 + lane];
            store_vt(sc, lane, wsp<bf16_t>(p, na ? WS_VTNA : WS_VTG) + (size_t)(b * (na ? 4 : 2) + h) * 64 * KV + pos0);
        } else if (job < 18) {
            const bool isq = job < 16; const int h = isq ? job - 12 : job - 16; const float g = p.in[isq ? I_GQG : I_GKG][l * 64 + lane] * (isq ? 0.125f * LOG2E : 1.f);
            bf16_t* dst = wsp<bf16_t>(p, isq ? WS_QG : WS_KG) + ((size_t)(b * (isq ? 4 : 2) + h) * KV + pos0) * 64;
            for (int t = 0; t < 64; ++t) { const float v = bf2f(P[(size_t)(row0 + t) * INWP + (isq ? O_GQ : O_GK) + h * 64 + lane]);
                const float ss = wave_sum(v * v); float y = v * rsqrtf(ss * (1.f / 64.f) + EPS) * g;
                const float o = __shfl_xor(y, 1);
                if (lat) { const float* cs = wsp<float>(p, WS_TRG) + ((size_t)(pos0 + t) * 32 + (lane >> 1)) * 2; y = (lane & 1) ? (o * cs[1] + y * cs[0]) : (y * cs[0] - o * cs[1]); }
                dst[t * 64 + lane] = f2bf(y); }
        } else if (job < 32) {
            const int which = (job - 20) >> 2, h = (job - 20) & 3, ch = which * 256 + h * 64 + lane;
            float w[5];
#pragma unroll
            for (int j = 0; j < 5; ++j) w[j] = p.in[I_DCONV][(size_t)l * 5 * 768 + j * 768 + ch];
            const int seq0 = lat ? 0 : SEQ, seqn = lat ? SEQ : CTX, rowb = bp2row(b, seq0);
            bf16_t* dst = wsp<bf16_t>(p, which == 0 ? WS_QD : which == 1 ? WS_KD : WS_VD) + ((size_t)(b * 4 + h) * KV + pos0) * 64;
            for (int t = 0; t < 64; ++t) { const int tl = pos0 - seq0 + t; float a = 0.f;
#pragma unroll
                for (int j = 0; j < 5; ++j) { const int tt = tl + j - 2; if (tt >= 0 && tt < seqn) a += bf2f(P[(size_t)(rowb + tt) * INWP + O_DQ + ch]) * w[j]; }
                float y = siluf(a);
                if (which < 2) { const float ss = wave_sum(y * y); y *= rsqrtf(ss + EPS); if (which == 0) y *= 0.125f; }
                dst[t * 64 + lane] = f2bf(y); }
        } else {
            const float* g16 = wsp<float>(p, WS_G16) + (size_t)(row0 + lane) * 16;
#pragma unroll
            for (int dh = 0; dh < 8; ++dh) { const int dir = dh >> 2, h = dh & 3; const float beta = sigmoidf(g16[dh]);
                const float x = g16[8 + dh] + p.in[I_DDT][l * 8 + dh]; const float sp = x > 20.f ? x : log1pf(__expf(x));
                const float g = -__expf(p.in[I_DALOG][l * 8 + dh]) * sp; const size_t o = ((size_t)((b * 4 + h) * 2 + dir)) * KV + pos0 + lane;
                wsp<float>(p, WS_DG)[o] = g; wsp<float>(p, WS_DBETA)[o] = beta; }
        }
    }
}

DEVI void mla_rows(const Params& p, char* lds, int l) {
    const int tid = threadIdx.x, lane = tid & 63, wid = tid >> 6;
    bf16_t* sc = (bf16_t*)(lds + wid * 8448);
    const bf16_t* P = wsp<bf16_t>(p, WS_P);
    constexpr int NITEM = NB * NCH * 8;
    for (int it = blockIdx.x * 8 + wid; it < NITEM; it += gridDim.x * 8) {
        const int job = it & 7, bb = it >> 3, b = bb / NCH, blk = bb % NCH, pos0 = blk * 64, row0 = bp2row(b, pos0), h = job & 3; const bool lat = pos0 < SEQ;
        if (job < 4) {
            const float g0 = p.in[I_MQNG][l * 96 + lane], g1 = lane < 32 ? p.in[I_MQNG][l * 96 + 64 + lane] : 0.f; const float qs = 0.10206207261596575f * LOG2E;
            bf16_t* dst = wsp<bf16_t>(p, WS_QM) + ((size_t)(b * 4 + h) * KV + pos0) * 96;
            for (int t = 0; t < 64; ++t) { const size_t row = row0 + t; float cs = 0.f;
#pragma unroll
                for (int j = 0; j < 4; ++j) { const float c = bf2f(P[row * INWP + O_CQ + j * 64 + lane]); cs += c * c; }
                const float sq = rsqrtf(wave_sum(cs) * (1.f / 256.f) + EPS);
                const bf16_t* uq = wsp<bf16_t>(p, WS_UQ) + row * 384 + h * 96;
                float y0 = sq * bf2f(uq[lane]), y1 = lane < 32 ? sq * bf2f(uq[64 + lane]) : 0.f;
                const float r = rsqrtf(wave_sum(y0 * y0 + y1 * y1) * (1.f / 96.f) + EPS); y0 *= r * g0; y1 *= r * g1;
                const float o = __shfl_xor(y1, 1);
                if (lat && lane < 32) { const float* t2 = wsp<float>(p, WS_TRM) + ((size_t)(pos0 + t) * 16 + (lane >> 1)) * 2; y1 = (lane & 1) ? (o * t2[1] + y1 * t2[0]) : (y1 * t2[0] - o * t2[1]); }
                dst[t * 96 + lane] = f2bf(y0 * qs); if (lane < 32) dst[t * 96 + 64 + lane] = f2bf(y1 * qs); }
        } else {
            const float g0 = p.in[I_MKNG][l * 96 + lane], g1 = lane < 32 ? p.in[I_MKNG][l * 96 + 64 + lane] : 0.f;
            bf16_t* dst = wsp<bf16_t>(p, WS_KM) + ((size_t)(b * 4 + h) * KV + pos0) * 96;
            for (int t = 0; t < 64; ++t) { const size_t row = row0 + t; float cs = 0.f;
#pragma unroll
                for (int j = 0; j < 2; ++j) { const float c = bf2f(P[row * INWP + O_CKV + j * 64 + lane]); cs += c * c; }
                const float skv = rsqrtf(wave_sum(cs) * (1.f / 128.f) + EPS);
                const bf16_t* ukv = wsp<bf16_t>(p, WS_UKV) + row * 512 + h * 128;
                float y0 = skv * bf2f(ukv[lane]), y1 = lane < 32 ? bf2f(P[row * INWP + O_KPE + lane]) : 0.f; const float v = skv * bf2f(ukv[64 + lane]);
                const float r = rsqrtf(wave_sum(y0 * y0 + y1 * y1) * (1.f / 96.f) + EPS); y0 *= r * g0; y1 *= r * g1;
                const float o = __shfl_xor(y1, 1);
                if (lat && lane < 32) { const float* t2 = wsp<float>(p, WS_TRM) + ((size_t)(pos0 + t) * 16 + (lane >> 1)) * 2; y1 = (lane & 1) ? (o * t2[1] + y1 * t2[0]) : (y1 * t2[0] - o * t2[1]); }
                dst[t * 96 + lane] = f2bf(y0); if (lane < 32) dst[t * 96 + 64 + lane] = f2bf(y1);
                sc[t * 66 + lane] = f2bf(v); }
            store_vt(sc, lane, wsp<bf16_t>(p, WS_VTM) + (size_t)(b * 4 + h) * 64 * KV + pos0);
        }
    }
}

DEVI void dn_chunk_local(const Params& p, char* lds, int l) {
    const int tid = threadIdx.x;
    float* L = (float*)lds;
    float* kS = L;
    float* vS = kS + 64 * 65;
    float* aS = vS + 64 * 65;
    float* tS = aS + 64 * 65;
    float* uS = tS + 64 * 65;
    float* wS = uS + 64 * 65;
    float* gc = wS + 64 * 65;
    float* be = gc + 64;
    float* tmp = be + 64;
    const int NITEM = NB * 4 * 2 * NCH;
    for (int it = blockIdx.x; it < NITEM; it += gridDim.x) {
        const int blk = it % NCH, dir = (it / NCH) & 1, bh = it / (NCH * 2), pos0 = blk * 64;
        const bf16_t* kd = wsp<bf16_t>(p, WS_KD) + ((size_t)bh * KV + pos0) * 64; const bf16_t* vd = wsp<bf16_t>(p, WS_VD) + ((size_t)bh * KV + pos0) * 64;
        const float* gg = wsp<float>(p, WS_DG) + ((size_t)(bh * 2 + dir)) * KV + pos0; const float* bt = wsp<float>(p, WS_DBETA) + ((size_t)(bh * 2 + dir)) * KV + pos0;
        __syncthreads();
        for (int i = tid; i < 4096; i += NTHREADS) { const int r = i >> 6, c = i & 63, tr = dir ? 63 - r : r; kS[r * 65 + c] = bf2f(kd[tr * 64 + c]); vS[r * 65 + c] = bf2f(vd[tr * 64 + c]); }
        if (tid < 64) { const int tr = dir ? 63 - tid : tid; float g = gg[tr];
#pragma unroll
            for (int o = 1; o < 64; o <<= 1) { const float t = __shfl_up(g, o); if (tid >= o) g += t; }
            gc[tid] = g; be[tid] = bt[tr]; }
        __syncthreads();
        for (int i = tid; i < 4096; i += NTHREADS) { const int r = i >> 6, c = i & 63; float s = 0.f;
            if (c < r) { for (int d = 0; d < 64; ++d) s += kS[r * 65 + d] * kS[c * 65 + d]; s *= be[r] * __expf(gc[r] - gc[c]); }
            aS[r * 65 + c] = s; }
        __syncthreads();
        for (int i = tid; i < 4096; i += NTHREADS) tS[(i >> 6) * 65 + (i & 63)] = 0.f;
        __syncthreads();
        if (tid < 64) { const int blk16 = tid >> 4, c = tid & 15, o = blk16 * 16; float t[16];
#pragma unroll
            for (int i = 0; i < 16; ++i) { float s = (i == c) ? 1.f : 0.f;
#pragma unroll
                for (int j = 0; j < 16; ++j) if (j < i) s -= aS[(o + i) * 65 + o + j] * t[j];
                t[i] = s; }
#pragma unroll
            for (int i = 0; i < 16; ++i) tS[(o + i) * 65 + o + c] = t[i]; }
        __syncthreads();
        {
            if (tid < 512) { const int q = tid >> 8, r = (tid >> 4) & 15, c = tid & 15, o = q * 32; float s = 0.f;
                for (int k = 0; k < 16; ++k) s += aS[(o + 16 + r) * 65 + o + k] * tS[(o + k) * 65 + o + c];
                tmp[q * 256 + r * 16 + c] = s; }
            __syncthreads();
            if (tid < 512) { const int q = tid >> 8, r = (tid >> 4) & 15, c = tid & 15, o = q * 32; float s = 0.f;
                for (int k = 0; k < 16; ++k) s += tS[(o + 16 + r) * 65 + o + 16 + k] * tmp[q * 256 + k * 16 + c];
                tS[(o + 16 + r) * 65 + o + c] = -s; }
            __syncthreads(); }
        { for (int i = tid; i < 1024; i += NTHREADS) { const int r = i >> 5, c = i & 31; float s = 0.f;
              for (int k = 0; k < 32; ++k) s += aS[(32 + r) * 65 + k] * tS[k * 65 + c];
              tmp[r * 33 + c] = s; }
          __syncthreads();
          for (int i = tid; i < 1024; i += NTHREADS) { const int r = i >> 5, c = i & 31; float s = 0.f;
              for (int k = 0; k < 32; ++k) s += tS[(32 + r) * 65 + 32 + k] * tmp[k * 33 + c];
              tS[(32 + r) * 65 + c] = -s; }
          __syncthreads(); }
        for (int i = tid; i < 4096; i += NTHREADS) { const int r = i >> 6, c = i & 63; float su = 0.f, sw = 0.f;
            for (int j = 0; j <= r; ++j) { const float t = tS[r * 65 + j] * be[j]; su += t * vS[j * 65 + c]; sw += t * __expf(gc[j]) * kS[j * 65 + c]; }
            uS[r * 65 + c] = su; wS[r * 65 + c] = sw; }
        __syncthreads();
        const size_t mo = (size_t)it * 4096;
        float* U = wsp<float>(p, WS_DU) + mo; float* W = wsp<float>(p, WS_DW) + mo; float* Mm = wsp<float>(p, WS_DM) + mo; float* Nn = wsp<float>(p, WS_DN) + mo;
        const float gl = gc[63];
        for (int i = tid; i < 4096; i += NTHREADS) { const int r = i >> 6, c = i & 63; U[i] = uS[r * 65 + c]; W[i] = wS[r * 65 + c];
            float sm = 0.f, sn = 0.f;
            for (int t = 0; t < 64; ++t) { const float kd_ = kS[t * 65 + r] * __expf(gl - gc[t]); sm += kd_ * wS[t * 65 + c]; sn += kd_ * uS[t * 65 + c]; }
            Mm[i] = (r == c ? __expf(gl) : 0.f) - sm; Nn[i] = sn; }
    }
}

DEVI void dn_scan(const Params& p, char* lds, int l, int item) {
    const int tid = threadIdx.x; float* S = (float*)lds;
    float* Mx = S + 64 * 33;
    const int half = item & 1, dir = (item >> 1) & 1, bh = item >> 2;
    __syncthreads();
    for (int i = tid; i < 64 * 32; i += NTHREADS) S[(i >> 5) * 33 + (i & 31)] = 0.f;
    for (int step = 0; step < NCH; ++step) {
        const int blk = dir ? (step < 4 ? 67 - step : 67 - step) : (step < 4 ? 64 + step : step - 4);
        const size_t mo = ((size_t)((bh * 2 + dir) * NCH + blk)) * 4096;
        const float* Mm = wsp<float>(p, WS_DM) + mo; const float* Nn = wsp<float>(p, WS_DN) + mo; float* Sd = wsp<float>(p, WS_DS) + mo;
        __syncthreads();
        for (int i = tid; i < 4096; i += NTHREADS) Mx[(i >> 6) * 65 + (i & 63)] = Mm[i];
        for (int i = tid; i < 2048; i += NTHREADS) { const int r = i >> 5, c = i & 31; Sd[r * 64 + half * 32 + c] = S[r * 33 + c]; }
        __syncthreads();
        float nv[4];
#pragma unroll
        for (int q = 0; q < 4; ++q) { const int i = tid + q * NTHREADS, r = i >> 5, c = i & 31; float s = Nn[r * 64 + half * 32 + c];
            for (int k = 0; k < 64; ++k) s += Mx[r * 65 + k] * S[k * 33 + c];
            nv[q] = s; }
        __syncthreads();
#pragma unroll
        for (int q = 0; q < 4; ++q) { const int i = tid + q * NTHREADS; S[(i >> 5) * 33 + (i & 31)] = nv[q]; }
    }
}

DEVI void dn_output(const Params& p, char* lds, int l) {
    const int tid = threadIdx.x; float* L = (float*)lds;
    float* qS = L; float* kS = qS + 64 * 65; float* wS = kS + 64 * 65; float* vn = wS + 64 * 65; float* at = vn + 64 * 65; float* Ss = at + 64 * 65; float* oS = Ss + 64 * 65;
    float* gc = oS + 64 * 65;
    const int NITEM = NB * 4 * NCH;
    for (int it = blockIdx.x; it < NITEM; it += gridDim.x) {
        const int blk = it % NCH, bh = it / NCH, b = bh >> 2, h = bh & 3, pos0 = blk * 64;
        if (l == 1 && blk >= 64) continue;
        const bf16_t* qd = wsp<bf16_t>(p, WS_QD) + ((size_t)bh * KV + pos0) * 64; const bf16_t* kd = wsp<bf16_t>(p, WS_KD) + ((size_t)bh * KV + pos0) * 64;
        __syncthreads();
        for (int i = tid; i < 4096; i += NTHREADS) oS[(i >> 6) * 65 + (i & 63)] = 0.f;
        for (int dir = 0; dir < 2; ++dir) {
            const size_t mo = ((size_t)((bh * 2 + dir) * NCH + blk)) * 4096;
            const float* U = wsp<float>(p, WS_DU) + mo; const float* W = wsp<float>(p, WS_DW) + mo; const float* Sg = wsp<float>(p, WS_DS) + mo;
            const float* gg = wsp<float>(p, WS_DG) + ((size_t)(bh * 2 + dir)) * KV + pos0;
            __syncthreads();
            for (int i = tid; i < 4096; i += NTHREADS) { const int r = i >> 6, c = i & 63, tr = dir ? 63 - r : r; qS[r * 65 + c] = bf2f(qd[tr * 64 + c]); kS[r * 65 + c] = bf2f(kd[tr * 64 + c]);
                wS[r * 65 + c] = W[i]; Ss[r * 65 + c] = Sg[i]; }
            if (tid < 64) { const int tr = dir ? 63 - tid : tid; float g = gg[tr];
#pragma unroll
                for (int o = 1; o < 64; o <<= 1) { const float t = __shfl_up(g, o); if (tid >= o) g += t; }
                gc[tid] = g; }
            __syncthreads();
            for (int i = tid; i < 4096; i += NTHREADS) { const int r = i >> 6, c = i & 63; float s = U[i], a = 0.f;
                for (int k = 0; k < 64; ++k) s -= wS[r * 65 + k] * Ss[k * 65 + c];
                vn[r * 65 + c] = s;
                if (c <= r) { for (int d = 0; d < 64; ++d) a += qS[r * 65 + d] * kS[c * 65 + d]; a *= __expf(gc[r] - gc[c]); }
                at[r * 65 + c] = a; }
            __syncthreads();
            for (int i = tid; i < 4096; i += NTHREADS) { const int r = i >> 6, c = i & 63, tr = dir ? 63 - r : r; float s = 0.f, a = 0.f;
                for (int k = 0; k < 64; ++k) s += qS[r * 65 + k] * Ss[k * 65 + c];
                for (int j = 0; j <= r; ++j) a += at[r * 65 + j] * vn[j * 65 + c];
                oS[tr * 65 + c] += s * __expf(gc[r]) + a; }
        }
        __syncthreads();
        { const int lane = tid & 63, wid = tid >> 6; const float g = p.in[I_DOUTG][l * 64 + lane];
          for (int t = wid; t < 64; t += 8) { const int row = bp2row(b, pos0 + t); const float v = oS[t * 65 + lane]; const float ss = wave_sum(v * v);
              const float gate = bf2f(wsp<bf16_t>(p, WS_P)[(size_t)row * INWP + O_DG + h * 64 + lane]);
              wsp<bf16_t>(p, WS_Y)[(size_t)row * D + 512 + h * 64 + lane] = f2bf(v * rsqrtf(ss * (1.f / 64.f) + EPS) * g * siluf(gate)); } }
    }
}

template <int DK> struct AttnW { bf16x8 qf[DK / 16]; f32x16 o[2]; float m, l; };
struct NoAdj { DEVI void operator()(f32x16 (&)[2], int) const {} };
DEVI bf16x8 pack8(float a, float b, float c, float d, float e, float f, float g, float h) { u32x4 w; w.x = pk2(a, b); w.y = pk2(c, d); w.z = pk2(e, f); w.w = pk2(g, h); return __builtin_bit_cast(bf16x8, w); }

template <int DK, class Adj> DEVI void attn_tile(AttnW<DK>& w, const bf16_t* Ks, const bf16_t* Vts, int lane, const Adj& adj) {
    const int r32 = lane & 31, hh = lane >> 5;
    f32x16 s[2];
#pragma unroll
    for (int kb = 0; kb < 2; ++kb) {
#pragma unroll
        for (int i = 0; i < 16; ++i) s[kb][i] = 0.f;
#pragma unroll
        for (int ks = 0; ks < DK / 16; ++ks) { const bf16x8 kf = *(const bf16x8*)(Ks + (kb * 32 + r32) * (DK + 8) + ks * 16 + 8 * hh);
            s[kb] = __builtin_amdgcn_mfma_f32_32x32x16_bf16(kf, w.qf[ks], s[kb], 0, 0, 0); } }
    adj(s, lane);
    float mx = s[0][0];
#pragma unroll
    for (int kb = 0; kb < 2; ++kb)
#pragma unroll
        for (int i = 0; i < 16; ++i) mx = fmaxf(mx, s[kb][i]);
    mx = fmaxf(mx, __shfl_xor(mx, 32));
    const float mn = fmaxf(w.m, mx), alpha = exp2f(w.m - mn); w.m = mn;
    float rs = 0.f;
#pragma unroll
    for (int kb = 0; kb < 2; ++kb)
#pragma unroll
        for (int i = 0; i < 16; ++i) { const float pv = exp2f(s[kb][i] - mn); s[kb][i] = pv; rs += pv; }
    w.l = w.l * alpha + rs;
#pragma unroll
    for (int i = 0; i < 16; ++i) { w.o[0][i] *= alpha; w.o[1][i] *= alpha; }
#pragma unroll
    for (int kb = 0; kb < 2; ++kb)
#pragma unroll
        for (int s2 = 0; s2 < 2; ++s2) { const int b8 = 8 * s2;
            const bf16x8 pf = pack8(s[kb][b8], s[kb][b8 + 1], s[kb][b8 + 2], s[kb][b8 + 3], s[kb][b8 + 4], s[kb][b8 + 5], s[kb][b8 + 6], s[kb][b8 + 7]);
#pragma unroll
            for (int db = 0; db < 2; ++db) { const bf16_t* vp = Vts + (db * 32 + r32) * 68 + kb * 32 + 16 * s2 + 4 * hh;
                const u32x2 lo = *(const u32x2*)vp, hi = *(const u32x2*)(vp + 8); u32x4 vv; vv.x = lo.x; vv.y = lo.y; vv.z = hi.x; vv.w = hi.y;
                w.o[db] = __builtin_amdgcn_mfma_f32_32x32x16_bf16(__builtin_bit_cast(bf16x8, vv), pf, w.o[db], 0, 0, 0); } }
}
template <int DK> DEVI void attn_init(AttnW<DK>& w, const bf16_t* qrow, int lane) {
#pragma unroll
    for (int ks = 0; ks < DK / 16; ++ks) w.qf[ks] = *(const bf16x8*)(qrow + ks * 16 + 8 * (lane >> 5));
#pragma unroll
    for (int i = 0; i < 16; ++i) { w.o[0][i] = 0.f; w.o[1][i] = 0.f; }
    w.m = -1e30f; w.l = 0.f;
}
template <int DK> DEVI void attn_finish(AttnW<DK>& w, bf16_t* yrow  , int lane) {
    const float lt = w.l + __shfl_xor(w.l, 32), inv = 1.f / lt; const int hh = lane >> 5;
#pragma unroll
    for (int db = 0; db < 2; ++db)
#pragma unroll
        for (int g = 0; g < 4; ++g) { u32x2 v; v.x = pk2(w.o[db][4 * g] * inv, w.o[db][4 * g + 1] * inv); v.y = pk2(w.o[db][4 * g + 2] * inv, w.o[db][4 * g + 3] * inv);
            *(u32x2*)(yrow + db * 32 + 8 * g + 4 * hh) = v; }
}

template <int DK> DEVI void attn_dense_unit(char* lds, const bf16_t* Q  , const bf16_t* Kh  , const bf16_t* Vth  ,
                                            int qpos0, int tile0, int ntiles, bf16_t* y0  ) {
    const int tid = threadIdx.x, lane = tid & 63, wid = tid >> 6;
    bf16_t* Ks = (bf16_t*)lds; bf16_t* Vts = Ks + 64 * (DK + 8);
    constexpr int KCH = 64 * DK / 8;
    AttnW<DK> w; attn_init(w, Q + (size_t)(qpos0 + wid * 32 + (lane & 31)) * DK, lane);
    u32x4 rk0, rk1, rv; rk1 = (u32x4){0u, 0u, 0u, 0u};
    auto prefetch = [&](int t) { const bf16_t* kt = Kh + (size_t)(tile0 + t) * 64 * DK; rk0 = *(const u32x4*)(kt + tid * 8); if (KCH > 512 && tid < KCH - 512) rk1 = *(const u32x4*)(kt + (512 + tid) * 8);
        rv = *(const u32x4*)(Vth + (size_t)(tid >> 3) * KV + (tile0 + t) * 64 + (tid & 7) * 8); };
    prefetch(0);
#pragma unroll 1
    for (int t = 0; t < ntiles; ++t) {
        __syncthreads();
        { const int key = tid / (DK / 8), c = tid % (DK / 8); *(u32x4*)(Ks + key * (DK + 8) + c * 8) = rk0;
          if (KCH > 512 && tid < KCH - 512) { const int ci = 512 + tid, k2 = ci / (DK / 8), c2 = ci % (DK / 8); *(u32x4*)(Ks + k2 * (DK + 8) + c2 * 8) = rk1; }
          bf16_t* vd = Vts + (tid >> 3) * 68 + (tid & 7) * 8; u32x2 a, b; a.x = rv.x; a.y = rv.y; b.x = rv.z; b.y = rv.w; *(u32x2*)vd = a; *(u32x2*)(vd + 4) = b; }
        __syncthreads();
        if (t + 1 < ntiles) prefetch(t + 1);
        attn_tile<DK>(w, Ks, Vts, lane, NoAdj());
    }
    attn_finish<DK>(w, y0 + (size_t)(wid * 32 + (lane & 31)) * D, lane);
}

struct NaAdj { const float* bias;   int c0;
    DEVI void operator()(f32x16 (&s)[2], int lane) const { const int hh = lane >> 5;
#pragma unroll
        for (int kb = 0; kb < 2; ++kb)
#pragma unroll
            for (int i = 0; i < 16; ++i) { const int wl = kb * 32 + (i & 3) + 8 * (i >> 2); const int wk = wl + 4 * hh; const bool ok = wk >= c0 && wk < c0 + 16;
                s[kb][i] = ok ? s[kb][i] + bias[wl] : -1e30f; } } };
DEVI void attn_na_unit(const Params& p, char* lds, int l, int b, int r) {
    const int tid = threadIdx.x, lane = tid & 63, wid = tid >> 6, hd = wid >> 1;
    bf16_t* Ks = (bf16_t*)lds;
    bf16_t* Vts = Ks + 4 * 64 * 72;
    float* bias = (float*)(Vts + 4 * 64 * 68);
    __syncthreads();
    for (int i = tid; i < 4 * 15 * 31; i += NTHREADS) bias[i] = p.in[I_NABIAS][(size_t)l * 4 * 15 * 31 + i] * LOG2E;
    const int cq = (wid & 1) * 32 + (lane & 31), r0 = min(max(r - 4, 0), GW - 8);
    AttnW<64> w; attn_init(w, wsp<bf16_t>(p, WS_QNA) + ((size_t)(b * 4 + hd) * KV + r * 64 + cq) * 64, lane);
    u32x4 rk[4], rv[4];
    auto prefetch = [&](int t) { const int key0 = t < 8 ? (r0 + t) * 64 : SEQ + (t - 8) * 64;
#pragma unroll
        for (int h = 0; h < 4; ++h) { rk[h] = *(const u32x4*)(wsp<bf16_t>(p, WS_KNA) + ((size_t)(b * 4 + h) * KV + key0) * 64 + tid * 8);
            rv[h] = *(const u32x4*)(wsp<bf16_t>(p, WS_VTNA) + ((size_t)(b * 4 + h) * 64 + (tid >> 3)) * KV + key0 + (tid & 7) * 8); } };
    prefetch(0);
#pragma unroll 1
    for (int t = 0; t < 12; ++t) {
        __syncthreads();
#pragma unroll
        for (int h = 0; h < 4; ++h) { *(u32x4*)(Ks + h * 64 * 72 + (tid >> 3) * 72 + (tid & 7) * 8) = rk[h];
            bf16_t* vd = Vts + h * 64 * 68 + (tid >> 3) * 68 + (tid & 7) * 8; u32x2 a, c; a.x = rv[h].x; a.y = rv[h].y; c.x = rv[h].z; c.y = rv[h].w; *(u32x2*)vd = a; *(u32x2*)(vd + 4) = c; }
        __syncthreads();
        if (t + 1 < 12) prefetch(t + 1);
        if (t < 8) { const int dr = (r0 + t) - r + 7; NaAdj adj{bias + (hd * 15 + dr) * 31 + 15 - cq + 4 * (lane >> 5), min(max(cq - 8, 0), GW - 16)}; attn_tile<64>(w, Ks + hd * 64 * 72, Vts + hd * 64 * 68, lane, adj); }
        else attn_tile<64>(w, Ks + hd * 64 * 72, Vts + hd * 64 * 68, lane, NoAdj());
    }
    attn_finish<64>(w, wsp<bf16_t>(p, WS_Y) + (size_t)(b * SEQ + r * 64 + cq) * D + hd * 64, lane);
}

DEVI void ph_mix(const Params& p, char* lds, int l) {
    { const int nscan = NB * 4 * 2 * 2; const int first = (int)gridDim.x >= 2 * nscan ? (int)gridDim.x - nscan : 0;
      for (int it = (int)blockIdx.x - first; it >= 0 && it < nscan; it += gridDim.x) dn_scan(p, lds, l, it); }
    __syncthreads();
    const int n_ctx = l == 0 ? 96 : 0, total = 1536 + n_ctx;
    bf16_t* Y = wsp<bf16_t>(p, WS_Y);
    for (int u = blockIdx.x; u < total; u += gridDim.x) {
        if (u >= 1024 && u < 1536) { const int v = u - 1024; attn_na_unit(p, lds, l, v >> 6, v & 63); continue; }
        int kind, b, h, qpos0, tile0, ntiles; size_t yrow;
        if (u < 512) { kind = 1; b = u >> 6; h = (u >> 4) & 3; qpos0 = (u & 15) * 256; tile0 = 0; ntiles = NCH; yrow = (size_t)b * SEQ + qpos0; }
        else if (u < 1024) { const int v = u - 512; kind = 2; b = v >> 6; h = (v >> 4) & 3; qpos0 = (v & 15) * 256; tile0 = 0; ntiles = NCH; yrow = (size_t)b * SEQ + qpos0; }
        else { const int v = u - 1536; kind = v >> 5; h = v & 3; b = (v >> 2) & 7; qpos0 = SEQ; tile0 = SEQ / 64; ntiles = 4; yrow = (size_t)NLAT + b * CTX; }
        if (kind == 2) attn_dense_unit<96>(lds, wsp<bf16_t>(p, WS_QM) + (size_t)(b * 4 + h) * KV * 96, wsp<bf16_t>(p, WS_KM) + (size_t)(b * 4 + h) * KV * 96,
                                           wsp<bf16_t>(p, WS_VTM) + (size_t)(b * 4 + h) * 64 * KV, qpos0, tile0, ntiles, Y + yrow * D + 768 + h * 64);
        else { const int kvh = kind == 0 ? b * 4 + h : b * 2 + (h >> 1);
            attn_dense_unit<64>(lds, wsp<bf16_t>(p, kind == 0 ? WS_QNA : WS_QG) + (size_t)(b * 4 + h) * KV * 64, wsp<bf16_t>(p, kind == 0 ? WS_KNA : WS_KG) + (size_t)kvh * KV * 64,
                                wsp<bf16_t>(p, kind == 0 ? WS_VTNA : WS_VTG) + (size_t)kvh * 64 * KV, qpos0, tile0, ntiles, Y + yrow * D + (kind == 0 ? 0 : 256) + h * 64); }
    }
}

DEVI void ph_router(const Params& p, char* lds, int l) {
    const int tid = threadIdx.x, lane = tid & 63, wid = tid >> 6;
    float* rw = (float*)lds;
    float* hs = (float*)(lds + 131072) + wid * 256;
    int* lcnt = (int*)(lds + 131072 + 8192);
    int* sel = (int*)(lds + 131072 + 8192 + 256);
    const int Mr = l == 0 ? MROWS : NLAT;
    const int per = (Mr + gridDim.x - 1) / gridDim.x, row_lo = blockIdx.x * per, row_hi = min(row_lo + per, Mr);
    __syncthreads();
    for (int i = tid; i < 1024 * 32; i += NTHREADS) rw[i] = p.in[I_RW][(size_t)l * 1024 * 32 + i];
    if (tid < 32) lcnt[tid] = 0;
    __syncthreads();
    const int e = lane & 31, kh = lane >> 5;
    for (int row = row_lo + wid; row < row_hi; row += 8) {
        float keep[4][4];
        norm_mod_row(wsp<float>(p, WS_XCUR) + (size_t)row * D, p.in[I_N2G] + l * D, mod_vec(p, l, row, 3), mod_vec(p, l, row, 4), wsp<bf16_t>(p, WS_HB) + (size_t)row * D, lane, keep);
        float acc = 0.f;
#pragma unroll
        for (int i = 0; i < 4; ++i) {
            *(f32x4*)(hs + lane * 4) = (f32x4){keep[i][0], keep[i][1], keep[i][2], keep[i][3]};
            for (int k = 0; k < 128; ++k) { const int kk = kh * 128 + k; acc += hs[kk] * rw[(size_t)(i * 256 + kk) * 32 + e]; }
        }
        acc += __shfl_xor(acc, 32); acc += p.in[I_RB][l * 32 + e];
        float tv[4]; int ti[4]; float cur = acc;
#pragma unroll
        for (int k = 0; k < 4; ++k) { float bv = cur; int bi = e;
#pragma unroll
            for (int o = 16; o > 0; o >>= 1) { const float ov = __shfl_xor(bv, o); const int oi = __shfl_xor(bi, o); if (ov > bv || (ov == bv && oi < bi)) { bv = ov; bi = oi; } }
            tv[k] = bv; ti[k] = bi; if (e == bi) cur = -3.0e38f; }
        const float e1 = __expf(tv[1] - tv[0]), e2 = __expf(tv[2] - tv[0]), e3 = __expf(tv[3] - tv[0]), inv = 1.f / (1.f + e1 + e2 + e3);
        if (lane == 0) { const float gt[4] = {inv, e1 * inv, e2 * inv, e3 * inv};
#pragma unroll
            for (int k = 0; k < 4; ++k) { wsp<float>(p, WS_GATE)[(size_t)row * 4 + k] = gt[k]; const int lp = atomicAdd(&lcnt[ti[k]], 1); sel[(row - row_lo) * 4 + k] = ti[k] | (lp << 8); } }
    }
    __syncthreads();
    if (tid < 32) { const int c = lcnt[tid]; lcnt[tid] = c ? (int)atomicAdd(wsp<unsigned>(p, WS_CTL) + CW_CNT + l * 64 + tid, (unsigned)c) : 0; }
    __syncthreads();
    for (int i = tid; i < (row_hi - row_lo) * 4; i += NTHREADS) { const int s = sel[i], ex = s & 255, lp = s >> 8; wsp<int>(p, WS_LIST)[(size_t)ex * MROWS + lcnt[ex] + lp] = (row_lo + (i >> 2)) * 4 + (i & 3); }
}

template <int WHICH> DEVI void ph_moe_gemm(const Params& p, char* lds, int l) {
    int* pre = (int*)(lds + G_LDS);
    __syncthreads();
    if (threadIdx.x == 0) { int s = 0; for (int e = 0; e < NEXP; ++e) { pre[e] = s; s += ((int)wsp<unsigned>(p, WS_CTL)[CW_CNT + l * 64 + e] + 127) >> 7; } pre[NEXP] = s; }
    __syncthreads();
    const int TR = pre[NEXP]; constexpr int NT = WHICH == 1 ? 16 : 8; const int total = TR * NT;
    for (int i = blockIdx.x; i < total; i += gridDim.x) {
        const int tr = i / NT, nt = i % NT; int e = 0; while (pre[e + 1] <= tr) ++e;
        const int mt = tr - pre[e], cnt = (int)wsp<unsigned>(p, WS_CTL)[CW_CNT + l * 64 + e];
        GUnit u; u.e = e; u.tr = tr; u.n0 = nt * 128; u.m0 = tr * 128; u.nvalid = min(128, cnt - mt * 128); u.rows = wsp<int>(p, WS_LIST) + (size_t)e * MROWS + mt * 128;
        if (WHICH == 1) { u.A = wsp<bf16_t>(p, WS_HB); u.lda = D; u.rshift = 2; u.B = wsp<bf16_t>(p, WS_W1) + (size_t)(l * NEXP + e) * 2048 * D; u.ldb = D;
            EpiH E{wsp<bf16_t>(p, WS_H), p.in[I_B1] + (size_t)l * NEXP * 2048}; gemm_unit(lds, u, D, E); }
        else { const int* rows = u.rows; u.rows = nullptr; u.A = wsp<bf16_t>(p, WS_H); u.lda = DEXP; u.rshift = 0; u.B = wsp<bf16_t>(p, WS_W2) + (size_t)(l * NEXP + e) * D * DEXP; u.ldb = DEXP;
            EpiY E{wsp<bf16_t>(p, WS_YEXP), p.in[I_B2] + (size_t)l * NEXP * D, rows}; gemm_unit(lds, u, DEXP, E); }
    }
}

DEVI void ph_combine(const Params& p, int l) {
    const int lane = threadIdx.x & 63, gw = blockIdx.x * 8 + (threadIdx.x >> 6), nw = gridDim.x * 8; const int Mr = l == 0 ? MROWS : NLAT;
    for (int row = gw; row < Mr; row += nw) {
        float* x = wsp<float>(p, WS_XCUR) + (size_t)row * D; const float* g5 = mod_vec(p, l, row, 5); const float* gt = wsp<float>(p, WS_GATE) + (size_t)row * 4;
        const bf16_t* ye = wsp<bf16_t>(p, WS_YEXP) + (size_t)row * 4 * D; float* dst = l == 0 ? x : p.out + (size_t)row * D;
#pragma unroll
        for (int i = 0; i < 4; ++i) { const int c = i * 256 + lane * 4; f32x4 f = (f32x4){0.f, 0.f, 0.f, 0.f};
#pragma unroll
            for (int k = 0; k < 4; ++k) { const u32x2 w = *(const u32x2*)(ye + (size_t)k * D + c); const float g = gt[k];
                f[0] += g * bf2f((bf16_t)(w.x & 0xffff)); f[1] += g * bf2f((bf16_t)(w.x >> 16)); f[2] += g * bf2f((bf16_t)(w.y & 0xffff)); f[3] += g * bf2f((bf16_t)(w.y >> 16)); }
            *(f32x4*)(dst + c) = *(const f32x4*)(x + c) + *(const f32x4*)(g5 + c) * f; }
        if (l == 0) norm_mod_row(x, p.in[I_N1G] + D, mod_vec(p, 1, row, 0), mod_vec(p, 1, row, 1), wsp<bf16_t>(p, WS_HB) + (size_t)row * D, lane);
    }
}

constexpr int N_PHASES = 22;
template <int PH> DEVI void run_phase(const Params& p, char* lds) {
    if constexpr (PH == 0) ph_prologue(p, lds);
    else if constexpr (PH == 1) ph_norm1_l0(p);
    else { constexpr int l = (PH - 2) / 10, q = (PH - 2) % 10;
        if constexpr (q == 0) ph_inproj(p, lds, l);
        else if constexpr (q == 1) ph_post(p, lds, l);
        else if constexpr (q == 2) { mla_rows(p, lds, l); dn_chunk_local(p, lds, l); }
        else if constexpr (q == 3) ph_mix(p, lds, l);
        else if constexpr (q == 4) dn_output(p, lds, l);
        else if constexpr (q == 5) ph_outproj(p, lds, l);
        else if constexpr (q == 6) ph_router(p, lds, l);
        else if constexpr (q == 7) ph_moe_gemm<1>(p, lds, l);
        else if constexpr (q == 8) ph_moe_gemm<2>(p, lds, l);
        else ph_combine(p, l);
    }
}

template <int PH> __global__ void __launch_bounds__(NTHREADS, 2) k_phase(Params p) {
    extern __shared__ __attribute__((aligned(16))) char smem[];
    run_phase<PH>(p, smem);
}

template <int PH> void launch_phase(const Params& p, int grid, hipStream_t s) {
    static bool attr = false;
    if (!attr) { hipFuncSetAttribute((const void*)k_phase<PH>, hipFuncAttributeMaxDynamicSharedMemorySize, LDS_BYTES); attr = true; }
    hipLaunchKernelGGL(k_phase<PH>, dim3(grid), dim3(NTHREADS), LDS_BYTES, s, p);
}
template <int PH> void launch_all(const Params& p, int grid, hipStream_t s) { launch_phase<PH>(p, grid, s); if constexpr (PH + 1 < N_PHASES) launch_all<PH + 1>(p, grid, s); }
}

extern "C" void kernel_launch(void* const* d_in, const int* in_sizes, int n_in, void* d_out, int out_size, void* d_ws, size_t ws_size, hipStream_t stream) {
    (void)in_sizes; (void)n_in; (void)out_size; (void)ws_size;
    Params p{};
    for (int i = 0; i < N_IN; ++i) p.in[i] = (const float*)d_in[i];
    p.out = (float*)d_out; p.ws = (unsigned char*)d_ws; p.ph_lo = 0; p.ph_hi = N_PHASES;
    hipMemsetAsync(d_ws, 0, CTL_BYTES, stream);
    launch_all<0>(p, 256, stream);
}
```

```cpp
#include <hip/hip_runtime.h>
#include <cstdint>
#include <cstdio>

#ifndef N_LAUNCH_MODE
#define N_LAUNCH_MODE 1
#endif

namespace {
typedef unsigned short bf16_t;
typedef short bf16x8 __attribute__((ext_vector_type(8)));
typedef float f32x4 __attribute__((ext_vector_type(4)));
typedef float f32x16 __attribute__((ext_vector_type(16)));
typedef unsigned u32x2 __attribute__((ext_vector_type(2)));
typedef unsigned u32x4 __attribute__((ext_vector_type(4)));
typedef int v4i_t __attribute__((ext_vector_type(4)));
typedef int v8i_t __attribute__((ext_vector_type(8)));

constexpr int D = 1024, NB = 8, SEQ = 4096, CTX = 256, GW = 64;
constexpr int NLAT = NB * SEQ, NCTX = NB * CTX, MROWS = NLAT + NCTX;
constexpr int KV = SEQ + CTX;
constexpr int INW = 2736, INWP = 2816;
constexpr int O_NAQ = 0, O_NAK = 256, O_NAV = 512, O_GQ = 768, O_GK = 1024, O_GV = 1152, O_DQ = 1280, O_DK = 1536, O_DV = 1792,
              O_DG = 2048, O_DB = 2304, O_DA = 2312, O_CQ = 2320, O_CKV = 2576, O_KPE = 2704;
constexpr int NEXP = 32, DEXP = 1024, TOPK = 4;
constexpr int NCH = KV / 64;
constexpr float EPS = 1e-6f, LOG2E = 1.4426950408889634f;
constexpr int NTHREADS = 512;

enum { I_X, I_C, I_CTX, I_CCTX, I_ADAW, I_ADAB, I_N1G, I_N2G, I_WIN, I_WOUT, I_NAQG, I_NAKG, I_NABIAS, I_GQG, I_GKG, I_DCONV, I_DALOG, I_DDT, I_DOUTG,
       I_MCQG, I_MCKVG, I_MWUQ, I_MWUKV, I_MQNG, I_MKNG, I_RW, I_RB, I_W1, I_B1, I_W2, I_B2, N_IN };

constexpr size_t al(size_t x) { return (x + 4095) & ~(size_t)4095; }
constexpr size_t WS_CTL = 0, CTL_BYTES = 1u << 16;
constexpr size_t WS_MODS = WS_CTL + CTL_BYTES;
constexpr size_t WS_TRG = al(WS_MODS + 2 * 9 * 6144 * 4);
constexpr size_t WS_TRM = al(WS_TRG + 4096 * 32 * 2 * 4);
constexpr size_t WS_WIN = al(WS_TRM + 4096 * 16 * 2 * 4);
constexpr size_t WS_WOUT = al(WS_WIN + (size_t)2 * INWP * D * 2);
constexpr size_t WS_WUQ = al(WS_WOUT + (size_t)2 * D * D * 2);
constexpr size_t WS_WUKV = al(WS_WUQ + 2 * 1024 * 384 * 2);
constexpr size_t WS_W1 = al(WS_WUKV + 2 * 512 * 128 * 2);
constexpr size_t WS_W2 = al(WS_W1 + (size_t)2 * NEXP * 2048 * D * 2);
constexpr size_t WS_XCUR = al(WS_W2 + (size_t)2 * NEXP * D * D * 2);
constexpr size_t WS_HB = al(WS_XCUR + (size_t)MROWS * D * 4);
constexpr size_t WS_LIST = al(WS_HB + (size_t)MROWS * D * 2);
constexpr size_t WS_GATE = al(WS_LIST + (size_t)NEXP * MROWS * 4);
constexpr size_t WS_SEL = al(WS_GATE + (size_t)MROWS * 4 * 4);
constexpr size_t WS_OVL = al(WS_SEL + (size_t)MROWS * 4 * 4);
constexpr size_t WS_P = WS_OVL;
constexpr size_t WS_G16 = al(WS_P + (size_t)MROWS * INWP * 2);
constexpr size_t HB64 = (size_t)NB * KV * 64 * 2;
constexpr size_t WS_QNA = al(WS_G16 + (size_t)MROWS * 16 * 4);
constexpr size_t WS_KNA = al(WS_QNA + 4 * HB64);
constexpr size_t WS_VTNA = al(WS_KNA + 4 * HB64);
constexpr size_t WS_QG = al(WS_VTNA + 4 * HB64);
constexpr size_t WS_KG = al(WS_QG + 4 * HB64);
constexpr size_t WS_VTG = al(WS_KG + 2 * HB64);
constexpr size_t WS_UQ = al(WS_VTG + 2 * HB64);
constexpr size_t WS_UKV = al(WS_UQ + (size_t)MROWS * 384 * 2);
constexpr size_t WS_QM = al(WS_UKV + (size_t)MROWS * 512 * 2);
constexpr size_t WS_KM = al(WS_QM + (size_t)NB * 4 * KV * 96 * 2);
constexpr size_t WS_VTM = al(WS_KM + (size_t)NB * 4 * KV * 96 * 2);
constexpr size_t WS_QD = al(WS_VTM + 4 * HB64);
constexpr size_t WS_KD = al(WS_QD + 4 * HB64);
constexpr size_t WS_VD = al(WS_KD + 4 * HB64);
constexpr size_t WS_KTD = al(WS_VD + 4 * HB64);
constexpr size_t WS_VTD = al(WS_KTD + 4 * HB64);
constexpr size_t WS_DG = al(WS_VTD + 4 * HB64);
constexpr size_t WS_DBETA = al(WS_DG + (size_t)NB * 4 * 2 * KV * 4);
constexpr size_t DNMAT = (size_t)NB * 4 * 2 * NCH * 4096 * 4;
constexpr size_t WS_DU = al(WS_DBETA + (size_t)NB * 4 * 2 * KV * 4);
constexpr size_t WS_DW = al(WS_DU + DNMAT);
constexpr size_t WS_DM = al(WS_DW + DNMAT);
constexpr size_t WS_DN = al(WS_DM + DNMAT);
constexpr size_t WS_DS = al(WS_DN + DNMAT);
constexpr size_t WS_Y = al(WS_DS + DNMAT);
constexpr size_t WS_END1 = al(WS_Y + (size_t)MROWS * D * 2);
constexpr int HROWS_MAX = MROWS * TOPK + NEXP * 256;
constexpr size_t WS_H = WS_OVL;
constexpr size_t WS_YEXP = al(WS_H + (size_t)HROWS_MAX * DEXP * 2);
constexpr size_t WS_END2 = al(WS_YEXP + (size_t)MROWS * TOPK * D * 2);
constexpr size_t WS_TOTAL = WS_END1 > WS_END2 ? WS_END1 : WS_END2;
static_assert(WS_TOTAL < (size_t)2100 * 1000 * 1000, "workspace map exceeds the guaranteed 4 x largest tensor");

constexpr int CW_BAR = 0;
constexpr int CW_CNT = 4096;
constexpr int CW_ERR = 8192;
constexpr int CW_Q = 12288;
constexpr int CW_MLAQ = 14336;
static_assert((CW_MLAQ + 2 * 64) * 4 <= (int)CTL_BYTES && (CW_Q + 16 * 64) <= CW_MLAQ && CW_CNT + 2 * 64 <= CW_ERR && 3456 <= CW_CNT, "control words inside the per-call memset");

constexpr int LDS_BYTES = 150528;

struct Params { const float* in[N_IN]; float* out; unsigned char* ws; int ph_lo, ph_hi; };

#define DEVI __device__ __forceinline__
DEVI int tid_fresh() { int t = threadIdx.x; asm volatile("" : "+v"(t)); return t; }
DEVI float bf2f(bf16_t x) { return __builtin_bit_cast(float, (unsigned)x << 16); }
DEVI bf16_t f2bf(float f) { unsigned u = __builtin_bit_cast(unsigned, f); return (bf16_t)((u + 0x7fffu + ((u >> 16) & 1u)) >> 16); }
typedef float f32x2_t __attribute__((ext_vector_type(2)));
typedef __bf16 bf16x2_t __attribute__((ext_vector_type(2)));
DEVI unsigned pk2(float lo, float hi) { const f32x2_t v = {lo, hi}; const bf16x2_t b = __builtin_convertvector(v, bf16x2_t); return __builtin_bit_cast(unsigned, b); }
DEVI void unpk8(const u32x4& w, float* v) {
    v[0] = __builtin_bit_cast(float, w.x << 16); v[1] = __builtin_bit_cast(float, w.x & 0xffff0000u); v[2] = __builtin_bit_cast(float, w.y << 16); v[3] = __builtin_bit_cast(float, w.y & 0xffff0000u);
    v[4] = __builtin_bit_cast(float, w.z << 16); v[5] = __builtin_bit_cast(float, w.z & 0xffff0000u); v[6] = __builtin_bit_cast(float, w.w << 16); v[7] = __builtin_bit_cast(float, w.w & 0xffff0000u); }
DEVI float clamp8(float x) { return fminf(fmaxf(x, -448.f), 448.f); }
DEVI unsigned pk4_fp8(float a, float b, float c, float d) { int w = __builtin_amdgcn_cvt_pk_fp8_f32(clamp8(a), clamp8(b), 0, false); w = __builtin_amdgcn_cvt_pk_fp8_f32(clamp8(c), clamp8(d), w, true); return (unsigned)w; }
constexpr float S8_Y = 16.f;
constexpr float S8_ACT = 8.f, S8_W = 32.f, S8_INV = 1.f / (S8_ACT * S8_W);
DEVI float wave_sum(float v) {
    int x;
    x = __builtin_bit_cast(int, v); v += __builtin_bit_cast(float, __builtin_amdgcn_update_dpp(0, x, 0xB1, 0xF, 0xF, true));
    x = __builtin_bit_cast(int, v); v += __builtin_bit_cast(float, __builtin_amdgcn_update_dpp(0, x, 0x4E, 0xF, 0xF, true));
    x = __builtin_bit_cast(int, v); v += __builtin_bit_cast(float, __builtin_amdgcn_update_dpp(0, x, 0x141, 0xF, 0xF, true));
    x = __builtin_bit_cast(int, v); v += __builtin_bit_cast(float, __builtin_amdgcn_update_dpp(0, x, 0x140, 0xF, 0xF, true));
    x = __builtin_bit_cast(int, v);
    return (__builtin_bit_cast(float, __builtin_amdgcn_readlane(x, 0)) + __builtin_bit_cast(float, __builtin_amdgcn_readlane(x, 16))) + (__builtin_bit_cast(float, __builtin_amdgcn_readlane(x, 32)) + __builtin_bit_cast(float, __builtin_amdgcn_readlane(x, 48)));
}
DEVI float sigmoidf(float y) { return __builtin_amdgcn_rcpf(1.f + __builtin_amdgcn_exp2f(-LOG2E * y)); }
DEVI float siluf(float y) { return y * sigmoidf(y); }
DEVI void row2bp(int row, int& b, int& pos) { if (row < NLAT) { b = row >> 12; pos = row & 4095; } else { const int r = row - NLAT; b = r >> 8; pos = SEQ + (r & 255); } }
DEVI int bp2row(int b, int pos) { return pos < SEQ ? b * SEQ + pos : NLAT + b * CTX + (pos - SEQ); }

template <class T> DEVI T* wsp(const Params& p, size_t off) { return (T*)(p.ws + off); }


#define XB_TMO      128
#define XB_XCNT(j)  (256  + 64 * (j))
#define XB_XSUB(j)  (1280 + 64 * (j))
#define XB_XGEN(j)  (2304 + 64 * (j))
#define XB_TOP      3328
#define XB_TOPGEN   3392
#define XCD_BAR_WORDS 3456
#define XB_SPIN_CAP (1u << 18)
#define LAS __attribute__((address_space(3)))
__device__ __forceinline__ unsigned xb_ld(unsigned* p)              { return __hip_atomic_load(p, __ATOMIC_RELAXED, __HIP_MEMORY_SCOPE_AGENT); }
__device__ __forceinline__ unsigned xb_add(unsigned* p, unsigned v) { return __hip_atomic_fetch_add(p, v, __ATOMIC_RELAXED, __HIP_MEMORY_SCOPE_AGENT); }
__device__ __forceinline__ unsigned xb_xcc_id() { return (unsigned)__builtin_amdgcn_s_getreg((3 << 11) | 20) & 0xFu; }
#define XB_SPIN(cond, bar) do { unsigned _sp = 0; while (cond) { __builtin_amdgcn_s_sleep(1); \
    if ((++_sp & 255u) == 0u) { if (xb_ld(&(bar)[XB_TMO])) break; if (_sp > XB_SPIN_CAP) { atomicAdd(&(bar)[XB_TMO], 1u); break; } } } } while (0)
struct XcdBarrier { unsigned* bar; unsigned x; volatile LAS unsigned* st; };
__device__ __forceinline__ XcdBarrier xcd_barrier_post(unsigned* bar, volatile LAS unsigned* st) {
    XcdBarrier b; b.bar = bar; b.x = xb_xcc_id(); b.st = st;
    if (threadIdx.x == 0) (void)xb_add(&bar[XB_XCNT(b.x)], 1u);
    return b;
}
__device__ __forceinline__ void xcd_barrier_complete(unsigned* bar, unsigned x, unsigned& nloc, unsigned& nx) {
    const unsigned G = gridDim.x * gridDim.y * gridDim.z;
    unsigned sum, cnt, mine, sp = 0u;
    for (;;) {
        sum = 0u; cnt = 0u; mine = 0u;
#pragma unroll
        for (unsigned j = 0; j < 16; ++j) { const unsigned c = xb_ld(&bar[XB_XCNT(j)]); sum += c; cnt += (c > 0u) ? 1u : 0u; mine = (j == x) ? c : mine; }
        if (sum == G) break;
        __builtin_amdgcn_s_sleep(1);
        if ((++sp & 255u) == 0u) { if (xb_ld(&bar[XB_TMO])) break; if (sp > XB_SPIN_CAP) { atomicAdd(&bar[XB_TMO], 1u); break; } }
    }
    nloc = mine > 0u ? mine : 1u; nx = cnt > 0u ? cnt : 1u;
}
__device__ __forceinline__ void xcd_barrier(const XcdBarrier& b) {
    asm volatile("s_waitcnt vmcnt(0)" ::: "memory");
    __syncthreads();
    if (threadIdx.x == 0) {
        unsigned* bar = b.bar;
        __builtin_amdgcn_s_waitcnt(0);
        unsigned nloc = b.st[0], nx = b.st[1];
        if (nloc == 0u) { xcd_barrier_complete(bar, b.x, nloc, nx); b.st[0] = nloc; b.st[1] = nx; }
        const unsigned old = xb_add(&bar[XB_XSUB(b.x)], 1u);
        const unsigned gen = old / nloc;
        if (old + 1u == (gen + 1u) * nloc) {
            __builtin_amdgcn_fence(__ATOMIC_RELEASE, "agent");
            asm volatile("s_waitcnt vmcnt(0)" ::: "memory");
            const unsigned og = xb_add(&bar[XB_TOP], 1u);
            const unsigned tg = og / nx;
            if (og + 1u == (tg + 1u) * nx) xb_add(&bar[XB_TOPGEN], 1u);
            else XB_SPIN(xb_ld(&bar[XB_TOPGEN]) == tg, bar);
            __builtin_amdgcn_fence(__ATOMIC_ACQUIRE, "agent");
            xb_add(&bar[XB_XGEN(b.x)], 1u);
            asm volatile("s_waitcnt vmcnt(0)" ::: "memory");
        } else {
            XB_SPIN(xb_ld(&bar[XB_XGEN(b.x)]) == gen, bar);
            __builtin_amdgcn_fence(__ATOMIC_ACQUIRE, "agent");
            asm volatile("s_waitcnt vmcnt(0)" ::: "memory");
        }
    }
    __syncthreads();
}

template <int NS> DEVI void tr_tile(const float* src, int ld, int k0, int n0, int nvalid, const float* rs, bf16_t* dst, int K, int perm, float* tile, bool fp8 = false) {
    const int tid = tid_fresh();
    { const int kk = tid >> 3, c8 = (tid & 7) * 8; f32x4 va[NS], vb[NS];
#pragma unroll
      for (int q = 0; q < NS; ++q) { const int n = n0 + q * 64 + c8;
          if (n < nvalid) { const float* sp = src + (size_t)(k0 + kk) * ld + n; va[q] = *(const f32x4*)sp; vb[q] = *(const f32x4*)(sp + 4); }
          else { va[q] = (f32x4){0.f, 0.f, 0.f, 0.f}; vb[q] = va[q]; } }
      const float sc = rs ? rs[k0 + kk] : 1.f;
#pragma unroll
      for (int q = 0; q < NS; ++q) { float* t = tile + q * 64 * 65 + kk * 65 + c8;
#pragma unroll
          for (int j = 0; j < 4; ++j) { t[j] = va[q][j] * sc; t[4 + j] = vb[q][j] * sc; } } }
    __syncthreads();
    { const int nn = tid >> 3, k8 = (tid & 7) * 8;
#pragma unroll
      for (int q = 0; q < NS; ++q) { const float* t = tile + q * 64 * 65; float v[8];
#pragma unroll
          for (int j = 0; j < 8; ++j) v[j] = t[(k8 + j) * 65 + nn];
          const int n = n0 + q * 64 + nn; int drow = n;
          if (perm) { const int j = n & 1023, hi = n >> 10; drow = (j >> 7) * 256 + hi * 128 + (j & 127); }
          if (!fp8) { u32x4 w; w.x = pk2(v[0], v[1]); w.y = pk2(v[2], v[3]); w.z = pk2(v[4], v[5]); w.w = pk2(v[6], v[7]); *(u32x4*)(dst + (size_t)drow * K + k0 + k8) = w; }
          else { u32x2 w8; w8.x = pk4_fp8(v[0] * S8_W, v[1] * S8_W, v[2] * S8_W, v[3] * S8_W); w8.y = pk4_fp8(v[4] * S8_W, v[5] * S8_W, v[6] * S8_W, v[7] * S8_W);
              *(u32x2*)((unsigned char*)dst + (size_t)drow * K + k0 + k8) = w8; } } }
    __syncthreads();
}

DEVI void ph_prologue(const Params& p, char* lds) {
    const int tid = tid_fresh(), lane = tid & 63, wid = tid >> 6;
    if (blockIdx.x < 192) {
        float* sv = (float*)lds;
        float* red = (float*)(lds + 36864);
        for (int i = tid; i < 9 * 1024; i += NTHREADS) { const int r = i >> 10, k = i & 1023; const float c = r < 8 ? p.in[I_C][r * 1024 + k] : p.in[I_CCTX][k]; sv[i] = siluf(c); }
        __syncthreads();
        for (int it = blockIdx.x; it < 192; it += gridDim.x) {
            const int l = it / 96, cg = it % 96;
            const float* W = p.in[I_ADAW] + (size_t)l * D * 6144 + cg * 64 + lane;
            float acc[9];
#pragma unroll
            for (int r = 0; r < 9; ++r) acc[r] = 0.f;
            for (int k = wid * 128; k < wid * 128 + 128; ++k) { const float w = W[(size_t)k * 6144];
#pragma unroll
                for (int r = 0; r < 9; ++r) acc[r] += sv[r * 1024 + k] * w; }
#pragma unroll
            for (int r = 0; r < 9; ++r) red[(wid * 9 + r) * 64 + lane] = acc[r];
            __syncthreads();
            for (int i = tid; i < 576; i += NTHREADS) { const int r = i >> 6, c = i & 63; float s = 0.f;
#pragma unroll
                for (int w = 0; w < 8; ++w) s += red[(w * 9 + r) * 64 + c];
                wsp<float>(p, WS_MODS)[(size_t)(l * 9 + r) * 6144 + cg * 64 + c] = s + p.in[I_ADAB][l * 6144 + cg * 64 + c]; }
            __syncthreads();
        }
    }
    for (int i = blockIdx.x * NTHREADS + tid; i < 4096 * 48; i += gridDim.x * NTHREADS) {
        const int t = i / 48, q = i % 48; const float row = (float)(t / GW), col = (float)(t % GW);
        if (q < 32) { const int f = q & 15; const float fr = powf(10000.f, -(float)f / 16.f); const float a = (q < 16 ? row : col) * fr; float s, c; sincosf(a, &s, &c);
            float* o = wsp<float>(p, WS_TRG) + ((size_t)t * 32 + q) * 2; o[0] = c; o[1] = s; }
        else { const int qq = q - 32, f = qq & 7; const float fr = powf(10000.f, -(float)f / 8.f); const float a = (qq < 8 ? row : col) * fr; float s, c; sincosf(a, &s, &c);
            float* o = wsp<float>(p, WS_TRM) + ((size_t)t * 16 + qq) * 2; o[0] = c; o[1] = s; }
    }
    float* tile = (float*)lds;
    constexpr int T_W1 = 64 * 128, T_W2 = 64 * 64, T_WIN = 2 * 16 * 11, T_WOUT = 2 * 64, T_WUQ = 2 * 4 * 2, T_WUKV = 2 * 2 * 2, T_WUZ = 2 * 18;
    constexpr int T_ALL = T_W1 + T_W2 + T_WIN + T_WOUT + T_WUQ + T_WUKV + T_WUZ;
    for (int it = blockIdx.x; it < T_ALL; it += gridDim.x) {
        int i = it;
        if (i < T_W1) { const int le = i >> 7, t = i & 127, kt = t >> 3, nt = t & 7;
            tr_tile<4>(p.in[I_W1] + (size_t)le * D * 2048, 2048, kt * 64, nt * 256, 2048, nullptr, (bf16_t*)(wsp<unsigned char>(p, WS_W1) + (size_t)le * 2048 * D), D, 1, tile, true); continue; }
        i -= T_W1;
        if (i < T_W2) { const int le = i >> 6, t = i & 63, kt = t >> 2, nt = t & 3;
            tr_tile<4>(p.in[I_W2] + (size_t)le * DEXP * D, D, kt * 64, nt * 256, D, nullptr, (bf16_t*)(wsp<unsigned char>(p, WS_W2) + (size_t)le * D * DEXP), DEXP, 0, tile, true); continue; }
        i -= T_W2;
        if (i < T_WIN) { const int l = i / 176, t = i % 176, kt = t / 11, nt = t % 11;
            tr_tile<4>(p.in[I_WIN] + (size_t)l * D * INW, INW, kt * 64, nt * 256, INW, nullptr, (bf16_t*)(wsp<unsigned char>(p, WS_WIN) + (size_t)l * INWP * D), D, 0, tile, true); continue; }
        i -= T_WIN;
        if (i < T_WOUT) { const int l = i >> 6, t = i & 63, kt = t >> 2, nt = t & 3;
            tr_tile<4>(p.in[I_WOUT] + (size_t)l * D * D, D, kt * 64, nt * 256, D, nullptr, (bf16_t*)(wsp<unsigned char>(p, WS_WOUT) + (size_t)l * D * D), D, 0, tile, true); continue; }
        i -= T_WOUT;
        if (i < T_WUQ) { const int l = i / 8, t = i % 8, kt = t / 2, nt = t % 2;
            tr_tile<4>(p.in[I_MWUQ] + (size_t)l * 256 * 384, 384, kt * 64, nt * 256, 384, p.in[I_MCQG] + l * 256, wsp<bf16_t>(p, WS_WUQ) + (size_t)l * 1024 * 384, 384, 0, tile); continue; }
        i -= T_WUQ;
        if (i < T_WUKV) { const int l = i / 4, t = i % 4, kt = t / 2, nt = t % 2;
            tr_tile<4>(p.in[I_MWUKV] + (size_t)l * 128 * 512, 512, kt * 64, nt * 256, 512, p.in[I_MCKVG] + l * 128, wsp<bf16_t>(p, WS_WUQ) + (size_t)l * 1024 * 384 + 384 * 384 + 256, 384, 0, tile); continue; }
        i -= T_WUKV;
        { const int l = i / 18, t = i % 18; bf16_t* base = wsp<bf16_t>(p, WS_WUQ) + (size_t)l * 1024 * 384;
            if (t < 6) tr_tile<2>(p.in[I_MWUQ], 384, 256 + (t / 3) * 64, (t % 3) * 128, 0, nullptr, base, 384, 0, tile);
            else { const int u = t - 6; tr_tile<2>(p.in[I_MWUQ], 384, (u / 3) * 64, (u % 3) * 128, 0, nullptr, base + 512 * 384, 384, 0, tile); } }
    }
}

DEVI void norm_mod_row(const float* x, const float* g, const float* shift, const float* scale, bf16_t* out, int lane, float (*keep)[4] = nullptr, unsigned char* out8 = nullptr) {
    f32x4 v[4]; float ss = 0.f;
#pragma unroll
    for (int i = 0; i < 4; ++i) { v[i] = *(const f32x4*)(x + i * 256 + lane * 4); ss += v[i][0] * v[i][0] + v[i][1] * v[i][1] + v[i][2] * v[i][2] + v[i][3] * v[i][3]; }
    ss = wave_sum(ss); const float r = rsqrtf(ss * (1.f / 1024.f) + EPS);
#pragma unroll
    for (int i = 0; i < 4; ++i) { const int c = i * 256 + lane * 4; const f32x4 gg = *(const f32x4*)(g + c), sh = *(const f32x4*)(shift + c), sc = *(const f32x4*)(scale + c);
        f32x4 y;
#pragma unroll
        for (int j = 0; j < 4; ++j) { y[j] = (v[i][j] * r * gg[j]) * (1.f + sc[j]) + sh[j]; if (keep) keep[i][j] = y[j]; }
        if (out8) *(unsigned*)(out8 + c) = pk4_fp8(y[0] * S8_ACT, y[1] * S8_ACT, y[2] * S8_ACT, y[3] * S8_ACT);
        else { u32x2 w; w.x = pk2(y[0], y[1]); w.y = pk2(y[2], y[3]); *(u32x2*)(out + c) = w; } }
}
DEVI const float* mod_vec(const Params& p, int l, int row, int which) {
    const int r = row < NLAT ? (row >> 12) : 8; return wsp<float>(p, WS_MODS) + (size_t)(l * 9 + r) * 6144 + which * 1024; }

DEVI void ph_norm1_l0(const Params& p) {
    const int tid = tid_fresh(), lane = tid & 63, gw = blockIdx.x * 8 + (tid >> 6), nw = gridDim.x * 8;
    for (int row = gw; row < MROWS; row += nw) {
        const float* x = row < NLAT ? p.in[I_X] + (size_t)row * D : p.in[I_CTX] + (size_t)(row - NLAT) * D;
        norm_mod_row(x, p.in[I_N1G], mod_vec(p, 0, row, 0), mod_vec(p, 0, row, 1), nullptr, lane, nullptr, wsp<unsigned char>(p, WS_HB) + (size_t)row * D);
    }
}

struct GUnit { const bf16_t* A; size_t lda; const int* rows; int nvalid, rshift; const bf16_t* B; size_t ldb; int m0, n0, e, tr; };
constexpr int G_LDS = 2 * 128 * 72 * 2;
template <class Epi> DEVI void gemm_unit(char* lds, const GUnit& u, int K, const Epi& E) {
    const int tid = tid_fresh(), lane = tid & 63, wid = tid >> 6, wm = wid >> 1, wn = wid & 1;
    bf16_t* As = (bf16_t*)lds; bf16_t* Bs = As + 128 * 72;
    const int r0 = tid >> 3, ch = tid & 7;
    const bf16_t* ap[2]; const bf16_t* bp[2];
#pragma unroll
    for (int i = 0; i < 2; ++i) { const int r = r0 + 64 * i;
        size_t arow; if (u.rows) arow = (r < u.nvalid) ? (size_t)(u.rows[r] >> u.rshift) : 0; else arow = (size_t)(u.m0 + r);
        ap[i] = u.A + arow * u.lda + ch * 8; bp[i] = u.B + (size_t)(u.n0 + r) * u.ldb + ch * 8; }
    f32x4 acc[2][4];
#pragma unroll
    for (int a = 0; a < 2; ++a)
#pragma unroll
        for (int b = 0; b < 4; ++b) acc[a][b] = (f32x4){0.f, 0.f, 0.f, 0.f};
    u32x4 ra[2], rb[2];
#pragma unroll
    for (int i = 0; i < 2; ++i) { ra[i] = *(const u32x4*)ap[i]; rb[i] = *(const u32x4*)bp[i]; }
    const int nk = K / 64;
    for (int kt = 0; kt < nk; ++kt) {
        __syncthreads();
#pragma unroll
        for (int i = 0; i < 2; ++i) { *(u32x4*)(As + (r0 + 64 * i) * 72 + ch * 8) = ra[i]; *(u32x4*)(Bs + (r0 + 64 * i) * 72 + ch * 8) = rb[i]; }
        __syncthreads();
        if (kt + 1 < nk) {
#pragma unroll
            for (int i = 0; i < 2; ++i) { ra[i] = *(const u32x4*)(ap[i] + (kt + 1) * 64); rb[i] = *(const u32x4*)(bp[i] + (kt + 1) * 64); } }
#pragma unroll
        for (int ks = 0; ks < 2; ++ks) {
            bf16x8 af[2], bfr[4];
#pragma unroll
            for (int mt = 0; mt < 2; ++mt) af[mt] = *(const bf16x8*)(As + (wm * 32 + mt * 16 + (lane & 15)) * 72 + ks * 32 + 8 * (lane >> 4));
#pragma unroll
            for (int nt = 0; nt < 4; ++nt) bfr[nt] = *(const bf16x8*)(Bs + (wn * 64 + nt * 16 + (lane & 15)) * 72 + ks * 32 + 8 * (lane >> 4));
#pragma unroll
            for (int mt = 0; mt < 2; ++mt)
#pragma unroll
                for (int nt = 0; nt < 4; ++nt) acc[mt][nt] = __builtin_amdgcn_mfma_f32_16x16x32_bf16(bfr[nt], af[mt], acc[mt][nt], 0, 0, 0);
        }
    }
    E(acc, u, wm, wn, lane);
}

struct EpiP { bf16_t* P; float* G16;
    DEVI void operator()(const f32x4 (&acc)[2][4], const GUnit& u, int wm, int wn, int lane) const {
#pragma unroll
        for (int mt = 0; mt < 2; ++mt)
#pragma unroll
            for (int nt = 0; nt < 4; ++nt) { const int row = u.m0 + wm * 32 + mt * 16 + (lane & 15), col = u.n0 + wn * 64 + nt * 16 + 4 * (lane >> 4); const f32x4 v = acc[mt][nt];
                u32x2 w; w.x = pk2(v[0], v[1]); w.y = pk2(v[2], v[3]); *(u32x2*)(P + (size_t)row * INWP + col) = w;
                if (col >= O_DB && col < O_DB + 16) *(f32x4*)(G16 + (size_t)row * 16 + (col - O_DB)) = v; }
    } };
struct EpiBf { bf16_t* O; int ldo;
    DEVI void operator()(const f32x4 (&acc)[2][4], const GUnit& u, int wm, int wn, int lane) const {
#pragma unroll
        for (int mt = 0; mt < 2; ++mt)
#pragma unroll
            for (int nt = 0; nt < 4; ++nt) { const int row = u.m0 + wm * 32 + mt * 16 + (lane & 15), col = u.n0 + wn * 64 + nt * 16 + 4 * (lane >> 4); const f32x4 v = acc[mt][nt];
                u32x2 w; w.x = pk2(v[0], v[1]); w.y = pk2(v[2], v[3]); *(u32x2*)(O + (size_t)row * ldo + col) = w; }
    } };
struct EpiOut { const Params* p; int l;
    DEVI void operator()(const f32x4 (&acc)[2][4], const GUnit& u, int wm, int wn, int lane) const {
#pragma unroll
        for (int mt = 0; mt < 2; ++mt) { const int row = u.m0 + wm * 32 + mt * 16 + (lane & 15);
            const float* base = l == 0 ? (row < NLAT ? p->in[I_X] + (size_t)row * D : p->in[I_CTX] + (size_t)(row - NLAT) * D) : wsp<float>(*p, WS_XCUR) + (size_t)row * D;
            const float* g = mod_vec(*p, l, row, 2); float* o = wsp<float>(*p, WS_XCUR) + (size_t)row * D;
#pragma unroll
            for (int nt = 0; nt < 4; ++nt) { const int col = u.n0 + wn * 64 + nt * 16 + 4 * (lane >> 4); const f32x4 bs = *(const f32x4*)(base + col), gg = *(const f32x4*)(g + col);
                *(f32x4*)(o + col) = bs + gg * acc[mt][nt]; } }
    } };
struct EpiH { bf16_t* H; const float* b1;
    DEVI void operator()(const f32x4 (&acc)[2][4], const GUnit& u, int wm, int wn, int lane) const {
        const float* bb = b1 + (size_t)u.e * 2048;
#pragma unroll
        for (int mt = 0; mt < 2; ++mt) { const size_t hrow = (size_t)u.tr * 128 + wm * 32 + mt * 16 + (lane & 15);
#pragma unroll
            for (int g = 0; g < 2; ++g) { const int acol = (u.n0 >> 1) + wn * 32 + g * 16 + 4 * (lane >> 4);
                const f32x4 bg = *(const f32x4*)(bb + acol), bl = *(const f32x4*)(bb + 1024 + acol); f32x4 o;
#pragma unroll
                for (int j = 0; j < 4; ++j) { const float glu = fminf(acc[mt][2 * g][j] + bg[j], 7.f); const float lin = fminf(fmaxf(acc[mt][2 * g + 1][j] + bl[j], -7.f), 7.f);
                    o[j] = glu * sigmoidf(1.702f * glu) * (lin + 1.f); }
                u32x2 w; w.x = pk2(o[0], o[1]); w.y = pk2(o[2], o[3]); *(u32x2*)(H + hrow * DEXP + acol) = w; } }
    } };
struct EpiY { bf16_t* Y; const float* b2; const int* rows;
    DEVI void operator()(const f32x4 (&acc)[2][4], const GUnit& u, int wm, int wn, int lane) const {
        const float* bb = b2 + (size_t)u.e * D;
#pragma unroll
        for (int mt = 0; mt < 2; ++mt) { const int r = wm * 32 + mt * 16 + (lane & 15); if (r >= u.nvalid) continue; const size_t yrow = (size_t)rows[r];
#pragma unroll
            for (int nt = 0; nt < 4; ++nt) { const int col = u.n0 + wn * 64 + nt * 16 + 4 * (lane >> 4); const f32x4 v = acc[mt][nt] + *(const f32x4*)(bb + col);
                u32x2 w; w.x = pk2(v[0], v[1]); w.y = pk2(v[2], v[3]); *(u32x2*)(Y + yrow * D + col) = w; } }
    } };

template <class Epi> DEVI void gemm_dense(char* lds, const bf16_t* A, size_t lda, const bf16_t* B, size_t ldb, int Mrows, int Ncols, int K, const Epi& E) {
    const int nt = Ncols / 128, total = (Mrows / 128) * nt;
    for (int i = blockIdx.x; i < total; i += gridDim.x) { GUnit u; u.A = A; u.lda = lda; u.rows = nullptr; u.nvalid = 128; u.rshift = 0; u.B = B; u.ldb = ldb; u.m0 = (i / nt) * 128; u.n0 = (i % nt) * 128; u.e = 0; u.tr = 0;
        gemm_unit(lds, u, K, E); }
}

namespace pg8 {
constexpr int BM = 256, BK = 64, HALF = 128, HTB = HALF * BK * 2, STAGE_BYTES = 8 * HTB;
DEVI int lds_byte(int r, int c) { const int st = (r >> 4) * 2 + (c >> 5), rr = r & 15, cc = c & 31, ob = rr * 64 + cc * 2; return st * 1024 + (ob ^ (((ob >> 9) & 1) << 5)); }
DEVI void stage_rc(int b, int& R, int& C) { const int st = b / 1024, sb = b % 1024, swz = sb ^ (((sb >> 9) & 1) << 5); R = (st >> 1) * 16 + swz / 64; C = (st & 1) * 32 + (swz % 64) / 2; }
DEVI int perm32(int rho) { const int n = rho >> 4, i = rho & 15; return 8 * (i >> 2) + 4 * n + (i & 3); }
struct Unit { int pm, pn, e, nvalid; const int* rows; };
template <bool FP8, bool ALIGN_EPI, class Epi, class Sched>
DEVI void gemm_phase(LAS unsigned char* lds, const int kbytes  , const Sched& S, const Epi& E) {
    const int tid = tid_fresh(), wid = __builtin_amdgcn_readfirstlane(tid >> 6), lane = tid & 63, wr = wid >> 2, wc = wid & 3, fr = lane & 15, fq = lane >> 4;
    const int nt = kbytes / (BK * 2);
    unsigned voffB[2];
#pragma unroll
    for (int i = 0; i < 2; ++i) { int R, C; stage_rc(tid * 16 + i * 8192, R, C); const int Rb = (R & ~31) + perm32(R & 31); voffB[i] = (unsigned)Rb * S.ldb_b + (unsigned)C * 2u; }
    const size_t kstep = (size_t)(BK * 2);
    const size_t hstepB = (size_t)HALF * S.ldb_b;
    const unsigned ldsw = (unsigned)wid * 1024u;
    const int aoff = lds_byte(wr * 64 + fr, fq * 8), boff = lds_byte(wc * 32 + fr, fq * 8);
#define PG8_SA(b, h) (((b) * 2 + (h)) * HTB)
#define PG8_SB(b, h) ((4 + (b) * 2 + (h)) * HTB)
#define PG8_STAGE(bufoff, gbase, voff) do { _Pragma("unroll") for (int _i = 0; _i < 2; ++_i) \
        __builtin_amdgcn_global_load_lds((const unsigned*)((const char*)(gbase) + (voff)[_i]), (LAS unsigned*)(lds + (bufoff) + ldsw + _i * 8192), 16, 0, 0); } while (0)
#define PG8_LDA(dst, b, h) do { _Pragma("unroll") for (int m = 0; m < 4; ++m) dst[m] = __builtin_shufflevector(*(const LAS v4i_t*)(lds + PG8_SA(b, h) + aoff + m * 2048), *(const LAS v4i_t*)(lds + PG8_SA(b, h) + aoff + m * 2048 + 1024), 0, 1, 2, 3, 4, 5, 6, 7); } while (0)
#define PG8_LDB(dst, b, h) do { _Pragma("unroll") for (int n = 0; n < 2; ++n) dst[n] = __builtin_shufflevector(*(const LAS v4i_t*)(lds + PG8_SB(b, h) + boff + n * 2048), *(const LAS v4i_t*)(lds + PG8_SB(b, h) + boff + n * 2048 + 1024), 0, 1, 2, 3, 4, 5, 6, 7); } while (0)
#define PG8_LO(x) __builtin_bit_cast(bf16x8, __builtin_shufflevector(x, x, 0, 1, 2, 3))
#define PG8_HI(x) __builtin_bit_cast(bf16x8, __builtin_shufflevector(x, x, 4, 5, 6, 7))
#define PG8_MMA(ai, bj, At, Bt) do { if constexpr (FP8) __builtin_amdgcn_sched_barrier(0); __builtin_amdgcn_s_setprio(1); _Pragma("unroll") for (int m = 0; m < 4; ++m) _Pragma("unroll") for (int n = 0; n < 2; ++n) { \
        if constexpr (FP8) asm volatile("v_mfma_scale_f32_16x16x128_f8f6f4 %0, %1, %2, %0, %3, %3 op_sel_hi:[0,0,0]" : "+v"(acc[ai][bj][m][n]) : "v"(Bt[n]), "v"(At[m]), "v"(one8)); \
        else { acc[ai][bj][m][n] = __builtin_amdgcn_mfma_f32_16x16x32_bf16(PG8_LO(Bt[n]), PG8_LO(At[m]), acc[ai][bj][m][n], 0, 0, 0); \
               acc[ai][bj][m][n] = __builtin_amdgcn_mfma_f32_16x16x32_bf16(PG8_HI(Bt[n]), PG8_HI(At[m]), acc[ai][bj][m][n], 0, 0, 0); } } __builtin_amdgcn_s_setprio(0); if constexpr (FP8) __builtin_amdgcn_sched_barrier(0); } while (0)
#define PG8_WAIT_V(n) asm volatile("s_waitcnt vmcnt(" #n ")" ::: "memory")
#define PG8_WAIT_L(n) asm volatile("s_waitcnt lgkmcnt(" #n ")" ::: "memory")
#define PG8_WAIT_VR(rl) do { static_assert(Epi::NST == 0 || Epi::NST == 8 || Epi::NST == 16, "NST"); if constexpr (Epi::NST == 16) { if (rl) PG8_WAIT_V(24); else PG8_WAIT_V(8); } else if constexpr (Epi::NST == 8) { if (rl) PG8_WAIT_V(16); else PG8_WAIT_V(8); } else PG8_WAIT_V(8); } while (0)
#define PG8_BAR __builtin_amdgcn_s_barrier()
#define PG8_SCHED __builtin_amdgcn_sched_barrier(0)
    Unit cur, nxt; int ui = 0;
    if (!S.next(0, cur)) return;
    unsigned vAc[2][2];
    LAS int* tab = (LAS int*)(lds + STAGE_BYTES + 1024);
    auto a_offsets = [&](const Unit& u, unsigned (&v)[2][2], bool from_tab) {
        int t2 = tid; asm volatile("" : "+v"(t2));
#pragma unroll
        for (int i = 0; i < 2; ++i) { int R, C; stage_rc(t2 * 16 + i * 8192, R, C);
#pragma unroll
            for (int h = 0; h < 2; ++h) { const int rr = h * HALF + R;
                unsigned arow; if constexpr (Sched::GATHER) { if (u.rows) { const int e = from_tab ? tab[rr] : u.rows[rr]; arow = rr < u.nvalid ? (unsigned)(e >> S.rshift) : 0u; } else arow = (unsigned)(u.pm * BM + rr); } else arow = (unsigned)(u.pm * BM + rr);
                v[h][i] = arow * S.lda_b + (unsigned)C * 2u; } } };
    a_offsets(cur, vAc, false);
    f32x4 acc[2][2][4][2];
#pragma unroll
    for (int a = 0; a < 2; ++a)
#pragma unroll
        for (int b = 0; b < 2; ++b)
#pragma unroll
            for (int m = 0; m < 4; ++m)
#pragma unroll
                for (int n = 0; n < 2; ++n) acc[a][b][m][n] = (f32x4){0.f, 0.f, 0.f, 0.f};
    v8i_t At[4], B0[2], B1[2];
    const int one8 = 0x7f7f7f7f;
    const char* cA = S.A;
    const char* cB = S.b_ptr(cur);
    PG8_STAGE(PG8_SB(0, 0), cB, voffB); PG8_STAGE(PG8_SB(0, 1), cB + hstepB, voffB); PG8_STAGE(PG8_SA(0, 0), cA, vAc[0]); PG8_STAGE(PG8_SA(0, 1), cA, vAc[1]);
    if (wr == 1) PG8_BAR;
    PG8_WAIT_V(2); PG8_BAR;
    PG8_STAGE(PG8_SB(1, 0), cB + kstep, voffB); PG8_STAGE(PG8_SA(1, 0), cA + kstep, vAc[0]); PG8_STAGE(PG8_SB(1, 1), cB + hstepB + kstep, voffB);
    PG8_WAIT_V(6); PG8_BAR;
    for (;;) {
        const bool has_next = S.next(ui + 1, nxt);
        const char* nB = has_next ? S.b_ptr(nxt) : cB;
        if constexpr (Sched::GATHER) { if (has_next && nxt.rows && wid == 0) __builtin_amdgcn_global_load_lds((const unsigned*)(nxt.rows + lane * 4), (LAS unsigned*)tab, 16, 0, 0); }
        for (int t = 0; t < nt; t += 2) {
            const bool last = (t == nt - 2), relax = (t == 0 && ui > 0);
            const char* a1 = cA + (size_t)(t + 1) * kstep;
            const char* a2 = last ? cA : cA + (size_t)(t + 2) * kstep; const char* b2 = last ? nB : cB + (size_t)(t + 2) * kstep;
            const char* a3 = a2 + kstep; const char* b3 = b2 + kstep;
            unsigned v2[2][2];
            if (last && has_next) a_offsets(nxt, v2, true);
            else {
#pragma unroll
                for (int h = 0; h < 2; ++h)
#pragma unroll
                    for (int i = 0; i < 2; ++i) v2[h][i] = vAc[h][i]; }
            PG8_LDB(B0, 0, 0); PG8_LDB(B1, 0, 1); PG8_SCHED; PG8_LDA(At, 0, 0); PG8_STAGE(PG8_SA(1, 1), a1, vAc[1]);
            PG8_WAIT_VR(relax); PG8_WAIT_L(0); PG8_BAR; PG8_MMA(0, 0, At, B0); PG8_MMA(0, 1, At, B1); PG8_BAR; PG8_SCHED;
            PG8_LDA(At, 0, 1); PG8_STAGE(PG8_SB(0, 0), b2, voffB); PG8_STAGE(PG8_SB(0, 1), b2 + hstepB, voffB); PG8_STAGE(PG8_SA(0, 0), a2, v2[0]);
            PG8_WAIT_VR(relax); PG8_WAIT_L(0); PG8_BAR; PG8_MMA(1, 0, At, B0); PG8_MMA(1, 1, At, B1); PG8_BAR; PG8_SCHED;
            PG8_LDB(B0, 1, 0); PG8_LDB(B1, 1, 1); PG8_SCHED; PG8_LDA(At, 1, 0); PG8_STAGE(PG8_SA(0, 1), a2, v2[1]);
            PG8_WAIT_V(8); PG8_WAIT_L(0); PG8_BAR; PG8_MMA(0, 0, At, B0); PG8_MMA(0, 1, At, B1); PG8_BAR; PG8_SCHED;
            PG8_LDA(At, 1, 1); PG8_STAGE(PG8_SB(1, 0), b3, voffB); PG8_STAGE(PG8_SB(1, 1), b3 + hstepB, voffB); PG8_STAGE(PG8_SA(1, 0), a3, v2[0]);
            PG8_WAIT_V(8); PG8_WAIT_L(0); PG8_BAR; PG8_MMA(1, 0, At, B0); PG8_MMA(1, 1, At, B1); PG8_BAR; PG8_SCHED;
            if (last) {
#pragma unroll
                for (int h = 0; h < 2; ++h)
#pragma unroll
                    for (int i = 0; i < 2; ++i) vAc[h][i] = v2[h][i]; }
        }
        if constexpr (ALIGN_EPI) { if (wr == 0) PG8_BAR; }
        if constexpr (FP8) asm volatile("s_nop 15\n\ts_nop 15" ::: "memory");
        E(acc, cur, wr, wc, fr, fq);
        if (!has_next) break;
#pragma unroll
        for (int a = 0; a < 2; ++a)
#pragma unroll
            for (int b = 0; b < 2; ++b)
#pragma unroll
                for (int m = 0; m < 4; ++m)
#pragma unroll
                    for (int n = 0; n < 2; ++n) acc[a][b][m][n] = (f32x4){0.f, 0.f, 0.f, 0.f};
        cur = nxt; cB = nB; ++ui;
        if constexpr (ALIGN_EPI) { if (wr == 1) PG8_BAR; }
    }
    PG8_WAIT_V(0);
    if constexpr (!ALIGN_EPI) { if (wr == 0) PG8_BAR; }
    PG8_BAR;
#undef PG8_SA
#undef PG8_SB
#undef PG8_STAGE
#undef PG8_LDA
#undef PG8_LDB
#undef PG8_MMA
#undef PG8_LO
#undef PG8_HI
#undef PG8_WAIT_V
#undef PG8_WAIT_VR
#undef PG8_WAIT_L
#undef PG8_BAR
#undef PG8_SCHED
}
struct DenseSched { static constexpr bool GATHER = false; const char* A; unsigned lda_b; const char* B; unsigned ldb_b; int rshift; int nM, nN, nwg, G, c;
    DEVI bool next(int i, Unit& u) const {
        const long L = (long)i * G + c; if (L >= nwg) return false;
        int wgid = (int)L; { const int q = nwg / 8, r = nwg % 8, xcd = wgid % 8, off = wgid / 8; wgid = (xcd < r ? xcd * (q + 1) : r * (q + 1) + (xcd - r) * q) + off; }
        const int nig = 8 * nN, gid = wgid / nig, fm = gid * 8, gsz = (nM - fm) < 8 ? (nM - fm) : 8;
        u.pm = fm + ((wgid % nig) % gsz); u.pn = (wgid % nig) / gsz; u.e = 0; u.nvalid = 256; u.rows = nullptr; return true; }
    DEVI const char* b_ptr(const Unit& u) const { return B + (size_t)u.pn * BM * ldb_b; } };
struct MoeSched { static constexpr bool GATHER = true; const char* A; unsigned lda_b; const char* B; unsigned ldb_b; int rshift; size_t estride_b; const int* pre; const unsigned* cnt; const int* list; int NT, total, G, c; bool gather;
    DEVI bool next(int i, Unit& u) const {
        const int cs = (G & 7) == 0 ? (c & 7) * (G >> 3) + (c >> 3) : c;
        const int L = i * G + cs; if (L >= total) return false;
        const int tr = L / NT; u.pn = L % NT; int e = 0; while (e < NEXP - 1 && __builtin_amdgcn_readfirstlane(pre[e + 1]) <= tr) ++e;
        const int mt = tr - __builtin_amdgcn_readfirstlane(pre[e]); u.e = e; u.pm = tr; u.nvalid = min(256, (int)__builtin_amdgcn_readfirstlane((int)cnt[e]) - mt * 256);
        u.rows = gather ? list + (size_t)e * MROWS + mt * 256 : nullptr; return true; }
    DEVI const char* b_ptr(const Unit& u) const { return B + (size_t)u.e * estride_b + (size_t)u.pn * BM * ldb_b; } };
}

struct Epi2P { static constexpr int NST = 16; bf16_t* P; float* G16;
    DEVI void operator()(const f32x4 (&acc)[2][2][4][2], const pg8::Unit& u, int wr, int wc, int fr, int fq) const {
#pragma unroll
        for (int ai = 0; ai < 2; ++ai)
#pragma unroll
            for (int m = 0; m < 4; ++m) { const size_t row = (size_t)u.pm * 256 + ai * 128 + wr * 64 + m * 16 + fr;
#pragma unroll
                for (int bj = 0; bj < 2; ++bj) { const int col = u.pn * 256 + bj * 128 + wc * 32 + 8 * fq; const f32x4 v0 = acc[ai][bj][m][0] * S8_INV, v1 = acc[ai][bj][m][1] * S8_INV;
                    u32x4 w; w.x = pk2(v0[0], v0[1]); w.y = pk2(v0[2], v0[3]); w.z = pk2(v1[0], v1[1]); w.w = pk2(v1[2], v1[3]); *(u32x4*)(P + row * INWP + col) = w;
                    if (col >= O_DB && col < O_DB + 16) { *(f32x4*)(G16 + row * 16 + (col - O_DB)) = v0; *(f32x4*)(G16 + row * 16 + (col - O_DB) + 4) = v1; } } }
    } };
struct Epi2UU { static constexpr int NST = 0; bf16_t* UQ; bf16_t* UKV;
    DEVI void operator()(const f32x4 (&acc)[2][2][4][2], const pg8::Unit& u, int wr, int wc, int fr_in, int fq) const {
        int fr = fr_in; asm volatile("" : "+v"(fr));
#pragma unroll
        for (int ai = 0; ai < 2; ++ai)
#pragma unroll
            for (int m = 0; m < 4; ++m) { const size_t row = (size_t)(unsigned)(u.pm * 256 + ai * 128 + wr * 64 + m * 16 + fr);
#pragma unroll
                for (int bj = 0; bj < 2; ++bj) { const int col = u.pn * 256 + bj * 128 + wc * 32 + 8 * fq; if (col >= 896) continue; const f32x4 v0 = acc[ai][bj][m][0], v1 = acc[ai][bj][m][1];
                    u32x4 w; w.x = pk2(v0[0], v0[1]); w.y = pk2(v0[2], v0[3]); w.z = pk2(v1[0], v1[1]); w.w = pk2(v1[2], v1[3]);
                    if (col < 384) *(u32x4*)(UQ + row * 384 + col) = w; else *(u32x4*)(UKV + row * 512 + (col - 384)) = w; } }
    } };
struct Epi2U { static constexpr int NST = 0; bf16_t* O; int ldo, ncols;
    DEVI void operator()(const f32x4 (&acc)[2][2][4][2], const pg8::Unit& u, int wr, int wc, int fr, int fq) const {
#pragma unroll
        for (int ai = 0; ai < 2; ++ai)
#pragma unroll
            for (int m = 0; m < 4; ++m) { const size_t row = (size_t)u.pm * 256 + ai * 128 + wr * 64 + m * 16 + fr;
#pragma unroll
                for (int bj = 0; bj < 2; ++bj) { const int col = u.pn * 256 + bj * 128 + wc * 32 + 8 * fq; if (col >= ncols) continue; const f32x4 v0 = acc[ai][bj][m][0], v1 = acc[ai][bj][m][1];
                    u32x4 w; w.x = pk2(v0[0], v0[1]); w.y = pk2(v0[2], v0[3]); w.z = pk2(v1[0], v1[1]); w.w = pk2(v1[2], v1[3]); *(u32x4*)(O + row * ldo + col) = w; } }
    } };
struct Epi2Out { static constexpr int NST = 0; const Params* p; int l;
    DEVI void operator()(const f32x4 (&acc)[2][2][4][2], const pg8::Unit& u, int wr, int wc, int fr, int fq) const {
#pragma unroll
        for (int ai = 0; ai < 2; ++ai)
#pragma unroll
            for (int m = 0; m < 4; ++m) { const int row = u.pm * 256 + ai * 128 + wr * 64 + m * 16 + fr;
                const float* g = mod_vec(*p, l, row, 2); bf16_t* o = wsp<bf16_t>(*p, WS_XCUR) + (size_t)row * D;
#pragma unroll
                for (int bj = 0; bj < 2; ++bj) { const int col = u.pn * 256 + bj * 128 + wc * 32 + 8 * fq; f32x4 b0, b1;
                    if (l == 0) { const float* base = row < NLAT ? p->in[I_X] + (size_t)row * D : p->in[I_CTX] + (size_t)(row - NLAT) * D; b0 = *(const f32x4*)(base + col); b1 = *(const f32x4*)(base + col + 4); }
                    else { float t[8]; unpk8(*(const u32x4*)(o + col), t); b0 = (f32x4){t[0], t[1], t[2], t[3]}; b1 = (f32x4){t[4], t[5], t[6], t[7]}; }
                    const f32x4 v0 = b0 + *(const f32x4*)(g + col) * (acc[ai][bj][m][0] * S8_INV), v1 = b1 + *(const f32x4*)(g + col + 4) * (acc[ai][bj][m][1] * S8_INV);
                    u32x4 w; w.x = pk2(v0[0], v0[1]); w.y = pk2(v0[2], v0[3]); w.z = pk2(v1[0], v1[1]); w.w = pk2(v1[2], v1[3]); *(u32x4*)(o + col) = w; } }
    } };
struct Epi2H { static constexpr int NST = 8; unsigned char* H; const float* b1;
    DEVI void operator()(const f32x4 (&acc)[2][2][4][2], const pg8::Unit& u, int wr, int wc, int fr, int fq) const {
        const float* bb = b1 + (size_t)u.e * 2048; const int acol = u.pn * 128 + wc * 32 + 8 * fq;
        f32x2_t bg[2][2], bl[2][2];
#pragma unroll
        for (int n = 0; n < 2; ++n) { const f32x4 g4 = *(const f32x4*)(bb + acol + 4 * n), l4 = *(const f32x4*)(bb + 1024 + acol + 4 * n);
#pragma unroll
            for (int jp = 0; jp < 2; ++jp) { bg[n][jp] = (f32x2_t){g4[2 * jp], g4[2 * jp + 1]}; bl[n][jp] = ((f32x2_t){l4[2 * jp], l4[2 * jp + 1]} + 1.f) * S8_ACT; } }
        const f32x2_t kinv = {S8_INV, S8_INV}, kinva = {S8_INV * S8_ACT, S8_INV * S8_ACT}, kexp = {-1.702f * LOG2E, -1.702f * LOG2E};
#pragma unroll
        for (int ai = 0; ai < 2; ++ai)
#pragma unroll
            for (int m = 0; m < 4; ++m) { const size_t hrow = (size_t)u.pm * 256 + ai * 128 + wr * 64 + m * 16 + fr; int w[2] = {0, 0};
#pragma unroll
                for (int n = 0; n < 2; ++n)
#pragma unroll
                    for (int jp = 0; jp < 2; ++jp) {
                        f32x2_t g = __builtin_elementwise_fma((f32x2_t){acc[ai][0][m][n][2 * jp], acc[ai][0][m][n][2 * jp + 1]}, kinv, bg[n][jp]);
                        g.x = fminf(g.x, 7.f); g.y = fminf(g.y, 7.f);
                        f32x2_t t = g * kexp; t.x = __builtin_amdgcn_exp2f(t.x); t.y = __builtin_amdgcn_exp2f(t.y);
                        t = t + 1.f; t.x = __builtin_amdgcn_rcpf(t.x); t.y = __builtin_amdgcn_rcpf(t.y);
                        f32x2_t li = __builtin_elementwise_fma((f32x2_t){acc[ai][1][m][n][2 * jp], acc[ai][1][m][n][2 * jp + 1]}, kinva, bl[n][jp]);
                        li.x = __builtin_amdgcn_fmed3f(li.x, -6.f * S8_ACT, 8.f * S8_ACT); li.y = __builtin_amdgcn_fmed3f(li.y, -6.f * S8_ACT, 8.f * S8_ACT);
                        const f32x2_t o = (g * t) * li;
                        if (jp == 0) w[n] = __builtin_amdgcn_cvt_pk_fp8_f32(o.x, o.y, w[n], false); else w[n] = __builtin_amdgcn_cvt_pk_fp8_f32(o.x, o.y, w[n], true); }
                u32x2 w2; w2.x = (unsigned)w[0]; w2.y = (unsigned)w[1]; *(u32x2*)(H + hrow * DEXP + acol) = w2; }
    } };
struct Epi2Y { static constexpr int NST = 16; static constexpr int DUMPBACK = (int)((WS_YEXP - WS_H - (size_t)HROWS_MAX * DEXP) / D); static_assert((size_t)DUMPBACK * D == WS_YEXP - WS_H - (size_t)HROWS_MAX * DEXP && DUMPBACK >= 256, "dump rows"); unsigned char* Y;   const float* b2; const int* list; const int* pre;
    DEVI void operator()(const f32x4 (&acc)[2][2][4][2], const pg8::Unit& u, int wr, int wc, int fr, int fq) const {
        const float* bb = b2 + (size_t)u.e * D + u.pn * 256 + wc * 32 + 8 * fq; const int* rows = list + (size_t)u.e * MROWS + (u.pm - __builtin_amdgcn_readfirstlane(pre[u.e])) * 256 + wr * 64 + fr;
        f32x4 bias[2][2]; int yr[2][4];
#pragma unroll
        for (int bj = 0; bj < 2; ++bj)
#pragma unroll
            for (int n = 0; n < 2; ++n) bias[bj][n] = *(const f32x4*)(bb + bj * 128 + 4 * n);
#pragma unroll
        for (int ai = 0; ai < 2; ++ai)
#pragma unroll
            for (int m = 0; m < 4; ++m) yr[ai][m] = rows[ai * 128 + m * 16];
        asm volatile("" ::: "memory");
#pragma unroll
        for (int ai = 0; ai < 2; ++ai)
#pragma unroll
            for (int m = 0; m < 4; ++m) { const int r = ai * 128 + wr * 64 + m * 16 + fr; const int yrow = r < u.nvalid ? yr[ai][m] : r - DUMPBACK;
#pragma unroll
                for (int bj = 0; bj < 2; ++bj) { const int col = u.pn * 256 + bj * 128 + wc * 32 + 8 * fq; const f32x4 v0 = (acc[ai][bj][m][0] * S8_INV + bias[bj][0]) * S8_Y, v1 = (acc[ai][bj][m][1] * S8_INV + bias[bj][1]) * S8_Y;
                    u32x2 w; w.x = pk4_fp8(v0[0], v0[1], v0[2], v0[3]); w.y = pk4_fp8(v1[0], v1[1], v1[2], v1[3]); *(u32x2*)(Y + (ptrdiff_t)yrow * D + col) = w; } }
    } };

DEVI void ph_inproj(const Params& p, char* lds, int l) {
    pg8::DenseSched S; S.A = (const char*)wsp<unsigned char>(p, WS_HB); S.lda_b = D; S.B = (const char*)(wsp<unsigned char>(p, WS_WIN) + (size_t)l * INWP * D); S.ldb_b = D; S.rshift = 0;
    S.nM = MROWS / 256; S.nN = INWP / 256; S.nwg = S.nM * S.nN; S.G = gridDim.x; S.c = blockIdx.x;
    Epi2P E{wsp<bf16_t>(p, WS_P), wsp<float>(p, WS_G16)};
    pg8::gemm_phase<true, true>((LAS unsigned char*)(LAS char*)lds, D, S, E);
}
DEVI void ph_outproj(const Params& p, char* lds, int l) {
    pg8::DenseSched S; S.A = (const char*)wsp<unsigned char>(p, WS_Y); S.lda_b = D; S.B = (const char*)(wsp<unsigned char>(p, WS_WOUT) + (size_t)l * D * D); S.ldb_b = D; S.rshift = 0;
    S.nM = (l == 0 ? MROWS : NLAT) / 256; S.nN = D / 256; S.nwg = S.nM * S.nN; S.G = gridDim.x; S.c = blockIdx.x;
    Epi2Out E{&p, l};
    pg8::gemm_phase<true, true>((LAS unsigned char*)(LAS char*)lds, D, S, E);
}

DEVI float dppf(float v, int ctrl_sel) {
    const int x = __builtin_bit_cast(int, v);
    const int r = ctrl_sel == 0 ? __builtin_amdgcn_update_dpp(0, x, 0xB1, 0xF, 0xF, true) : ctrl_sel == 1 ? __builtin_amdgcn_update_dpp(0, x, 0x4E, 0xF, 0xF, true) : __builtin_amdgcn_update_dpp(0, x, 0x141, 0xF, 0xF, true);
    return __builtin_bit_cast(float, r); }
DEVI float sum8(float v) { v += dppf(v, 0); v += dppf(v, 1); v += dppf(v, 2); return v; }
DEVI u32x4 pk8(const float* y) { u32x4 w; w.x = pk2(y[0], y[1]); w.y = pk2(y[2], y[3]); w.z = pk2(y[4], y[5]); w.w = pk2(y[6], y[7]); return w; }
DEVI unsigned elem16(const u32x4& w, int j) { const unsigned x = (j >> 1) == 0 ? w.x : (j >> 1) == 1 ? w.y : (j >> 1) == 2 ? w.z : w.w; return (j & 1) ? (x >> 16) : (x & 0xffffu); }
DEVI void stT8(bf16_t* dstT, const u32x4 (&w)[8]) {
#pragma unroll
    for (int j = 0; j < 8; ++j) { u32x4 o; o.x = elem16(w[0], j) | (elem16(w[1], j) << 16); o.y = elem16(w[2], j) | (elem16(w[3], j) << 16); o.z = elem16(w[4], j) | (elem16(w[5], j) << 16); o.w = elem16(w[6], j) | (elem16(w[7], j) << 16);
        *(u32x4*)(dstT + (size_t)j * KV) = o; } }
DEVI void ld8(const bf16_t* src, float* v) { const u32x4 w = *(const u32x4*)src;
    v[0] = __builtin_bit_cast(float, w.x << 16); v[1] = __builtin_bit_cast(float, w.x & 0xffff0000u); v[2] = __builtin_bit_cast(float, w.y << 16); v[3] = __builtin_bit_cast(float, w.y & 0xffff0000u);
    v[4] = __builtin_bit_cast(float, w.z << 16); v[5] = __builtin_bit_cast(float, w.z & 0xffff0000u); v[6] = __builtin_bit_cast(float, w.w << 16); v[7] = __builtin_bit_cast(float, w.w & 0xffff0000u); }
DEVI void st8(bf16_t* dst, const float* y) { u32x4 w; w.x = pk2(y[0], y[1]); w.y = pk2(y[2], y[3]); w.z = pk2(y[4], y[5]); w.w = pk2(y[6], y[7]); *(u32x4*)dst = w; }
template <int N> DEVI void stT(bf16_t* dstT  , const float* y) {
#pragma unroll
    for (int d = 0; d < N; ++d) dstT[(size_t)d * KV] = f2bf(y[d]); }
DEVI void store_vt(bf16_t* sc, int lane, bf16_t* dstT  ) {
#pragma unroll
    for (int c = 0; c < 8; ++c) { u32x4 w; unsigned t[4];
#pragma unroll
        for (int j = 0; j < 4; ++j) t[j] = (unsigned)sc[(c * 8 + 2 * j) * 66 + lane] | ((unsigned)sc[(c * 8 + 2 * j + 1) * 66 + lane] << 16);
        w.x = t[0]; w.y = t[1]; w.z = t[2]; w.w = t[3]; *(u32x4*)(dstT + (size_t)lane * KV + c * 8) = w; }
}

#ifndef SUBDUP
#define SUBDUP 0
#endif
DEVI void ph_post(const Params& p, char* lds, int l) {
    { pg8::DenseSched S; S.A = (const char*)(wsp<bf16_t>(p, WS_P) + O_CQ); S.lda_b = INWP * 2; S.B = (const char*)(wsp<bf16_t>(p, WS_WUQ) + (size_t)l * 1024 * 384); S.ldb_b = 384 * 2; S.rshift = 0;
      S.nM = MROWS / 256; S.nN = 4; S.nwg = S.nM * S.nN; S.G = gridDim.x; S.c = blockIdx.x;
      Epi2UU E{wsp<bf16_t>(p, WS_UQ), wsp<bf16_t>(p, WS_UKV)};
      pg8::gemm_phase<false, true>((LAS unsigned char*)(LAS char*)lds, 384 * 2, S, E); }
    __syncthreads();
    const int tid = tid_fresh(), lane = tid & 63, wid = __builtin_amdgcn_readfirstlane(tid >> 6);
    const bf16_t* P = wsp<bf16_t>(p, WS_P);
    float* gt = (float*)(lds + 40960);
    float* cw = gt + 256;
    for (int i = tid; i < 256; i += NTHREADS) { const int w4 = i >> 6, d = i & 63; gt[i] = p.in[w4 == 0 ? I_NAQG : w4 == 1 ? I_NAKG : w4 == 2 ? I_GQG : I_GKG][l * 64 + d] * ((w4 & 1) ? 1.f : 0.125f * LOG2E); }
    for (int i = tid; i < 3840; i += NTHREADS) cw[i] = p.in[I_DCONV][(size_t)l * 3840 + i];
    __syncthreads();
    constexpr int NJOB = 33, NITEM = NB * NCH * NJOB;
    for (int it0 = blockIdx.x * 8 + wid; it0 < NITEM; it0 += gridDim.x * 8) {
        const int job = it0 % NJOB, bb = it0 / NJOB, b = bb / NCH, blk = bb % NCH, pos0 = blk * 64, row0 = bp2row(b, pos0);
        int ln = lane; asm volatile("" : "+v"(ln));
        const int tk = ln >> 3, ch = ln & 7; const bool lat = pos0 < SEQ;
        const size_t prow = (size_t)(row0 + tk * 8) * INWP + ch * 8;
        const int posl = pos0 + tk * 8;
        if (job < 8 || (job >= 12 && job < 18)) {
            const bool na = job < 8; const bool isq = na ? job < 4 : job < 16; const int h = na ? (job & 3) : (isq ? job - 12 : job - 16);
            const int off = (na ? (isq ? O_NAQ : O_NAK) : (isq ? O_GQ : O_GK)) + h * 64; const float* gp = gt + ((na ? 0 : 2) + (isq ? 0 : 1)) * 64 + ch * 8;
            float g[8];
#pragma unroll
            for (int d = 0; d < 8; ++d) g[d] = gp[d];
            u32x4 w[8];
#pragma unroll
            for (int it = 0; it < 8; ++it) w[it] = *(const u32x4*)(P + prow + (size_t)it * INWP + off);
            bf16_t* dst = wsp<bf16_t>(p, na ? (isq ? WS_QNA : WS_KNA) : (isq ? WS_QG : WS_KG)) + ((size_t)(b * ((na || isq) ? 4 : 2) + h) * KV + posl) * 64 + ch * 8;
            const bool rope = !na && lat;
            f32x4 rt[8][2];
            if (rope) {
#pragma unroll
                for (int it = 0; it < 8; ++it) { const float* cs = wsp<float>(p, WS_TRG) + (size_t)(posl + it) * 64 + ch * 8; rt[it][0] = *(const f32x4*)cs; rt[it][1] = *(const f32x4*)(cs + 4); } }
            asm volatile("" ::: "memory");
#pragma unroll
            for (int it = 0; it < 8; ++it) { float v[8]; unpk8(w[it], v); float ss = 0.f;
#pragma unroll
                for (int d = 0; d < 8; ++d) ss += v[d] * v[d];
                const float r = rsqrtf(sum8(ss) * (1.f / 64.f) + EPS);
#pragma unroll
                for (int d = 0; d < 8; ++d) v[d] *= r * g[d];
                if (rope) { const f32x4 t0 = rt[it][0], t1 = rt[it][1];
                    const float a0 = v[0], a1 = v[1], b0 = v[2], b1 = v[3], c0 = v[4], c1 = v[5], d0 = v[6], d1 = v[7];
                    v[0] = a0 * t0[0] - a1 * t0[1]; v[1] = a0 * t0[1] + a1 * t0[0]; v[2] = b0 * t0[2] - b1 * t0[3]; v[3] = b0 * t0[3] + b1 * t0[2];
                    v[4] = c0 * t1[0] - c1 * t1[1]; v[5] = c0 * t1[1] + c1 * t1[0]; v[6] = d0 * t1[2] - d1 * t1[3]; v[7] = d0 * t1[3] + d1 * t1[2]; }
                *(u32x4*)(dst + (size_t)it * 64) = pk8(v); }
        } else if (job < 12 || (job >= 18 && job < 20)) {
            const bool na = job < 12; const int h = na ? job - 8 : job - 18, off = (na ? O_NAV : O_GV) + h * 64;
            u32x4 w[8];
#pragma unroll
            for (int it = 0; it < 8; ++it) w[it] = *(const u32x4*)(P + prow + (size_t)it * INWP + off);
            stT8(wsp<bf16_t>(p, na ? WS_VTNA : WS_VTG) + ((size_t)(b * (na ? 4 : 2) + h) * 64 + ch * 8) * KV + posl, w);
        } else if (job < 32) {
            const int which = (job - 20) >> 2, h = (job - 20) & 3, ch0 = which * 256 + h * 64;
            const int seq0 = lat ? 0 : SEQ, seqn = lat ? SEQ : CTX, tl0 = posl - seq0 - 2;
            u32x4 xw[12];
#pragma unroll
            for (int q = 0; q < 12; ++q) { const int tt = tl0 + q; xw[q] = (tt >= 0 && tt < seqn) ? *(const u32x4*)(P + prow + (long)(q - 2) * INWP + O_DQ + ch0) : (u32x4){0u, 0u, 0u, 0u}; }
            float tw[5][8];
#pragma unroll
            for (int j = 0; j < 5; ++j)
#pragma unroll
                for (int d = 0; d < 8; ++d) tw[j][d] = cw[j * 768 + ch0 + ch * 8 + d];
            bf16_t* dst = wsp<bf16_t>(p, which == 0 ? WS_QD : which == 1 ? WS_KD : WS_VD) + ((size_t)(b * 4 + h) * KV + posl) * 64 + ch * 8;
            u32x4 ow[8];
#pragma unroll
            for (int it = 0; it < 8; ++it) { float a[8];
#pragma unroll
                for (int d = 0; d < 8; ++d) a[d] = 0.f;
#pragma unroll
                for (int j = 0; j < 5; ++j) { float x[8]; unpk8(xw[it + j], x);
#pragma unroll
                    for (int d = 0; d < 8; ++d) a[d] += x[d] * tw[j][d]; }
                float ss = 0.f;
#pragma unroll
                for (int d = 0; d < 8; ++d) { a[d] = siluf(a[d]); ss += a[d] * a[d]; }
                if (which < 2) { const float r = rsqrtf(sum8(ss) + EPS) * (which == 0 ? 0.125f : 1.f);
#pragma unroll
                    for (int d = 0; d < 8; ++d) a[d] *= r; }
                ow[it] = pk8(a); *(u32x4*)(dst + (size_t)it * 64) = ow[it]; }
            if (which > 0) stT8(wsp<bf16_t>(p, which == 1 ? WS_KTD : WS_VTD) + ((size_t)(b * 4 + h) * 64 + ch * 8) * KV + posl, ow);
        } else {
            const float* g16 = wsp<float>(p, WS_G16) + (size_t)(row0 + ln) * 16;
#pragma unroll
            for (int dh = 0; dh < 8; ++dh) { const int dir = dh >> 2, h = dh & 3; const float beta = sigmoidf(g16[dh]);
                const float x = g16[8 + dh] + p.in[I_DDT][l * 8 + dh]; const float sp = x > 20.f ? x : log1pf(__expf(x));
                const float g = -__expf(p.in[I_DALOG][l * 8 + dh]) * sp; const size_t o = ((size_t)((b * 4 + h) * 2 + dir)) * KV + pos0 + ln;
                wsp<float>(p, WS_DG)[o] = g; wsp<float>(p, WS_DBETA)[o] = beta; }
        }
    }
}

DEVI void mla_rows(const Params& p, const float* gq, int l, int lane) {
    const bf16_t* P = wsp<bf16_t>(p, WS_P); const float* gk = gq + 96;
    constexpr int NITEM = NB * NCH * 8;
    unsigned* qh = wsp<unsigned>(p, WS_CTL) + CW_MLAQ + l * 64;
    for (;;) {
        int it0 = 0; if (lane == 0) it0 = (int)atomicAdd(qh, 1u);
        it0 = __builtin_amdgcn_readfirstlane(it0);
        if (it0 >= NITEM) break;
        int job = it0 & 7; asm volatile("" : "+v"(job));
        const int bb = it0 >> 3, b = bb / NCH, blk = bb % NCH, pos0 = blk * 64, row0 = bp2row(b, pos0), h = job & 3; const bool lat = pos0 < SEQ;
        int ln = lane; asm volatile("" : "+v"(ln));
        const int tk = ln >> 3, ch = ln & 7; const bool isq = job < 4, tail = ch < 4;
        const size_t rowl = (size_t)(row0 + tk * 8); const int posl = pos0 + tk * 8;
        const float* gsrc = (isq ? gq : gk); float g0[8], g1[8];
#pragma unroll
        for (int d = 0; d < 8; ++d) { g0[d] = gsrc[ch * 8 + d]; g1[d] = tail ? gsrc[64 + ch * 8 + d] : 0.f; }
        const float qs = isq ? 0.10206207261596575f * LOG2E : 1.f;
        bf16_t* dst = wsp<bf16_t>(p, isq ? WS_QM : WS_KM) + ((size_t)(b * 4 + h) * KV + posl) * 96 + ch * 8;
        u32x4 vw[8];
#pragma unroll
        for (int hb = 0; hb < 2; ++hb) {
            u32x4 c0[4], c1[4], c2[4], c3[4], u0[4], u1[4]; f32x4 rt0[4], rt1[4];
#pragma unroll
            for (int j = 0; j < 4; ++j) { const int it = hb * 4 + j; const size_t row = rowl + it;
                const bf16_t* cp = P + row * INWP + (isq ? O_CQ : O_CKV) + ch * 8;
                c0[j] = *(const u32x4*)cp; c1[j] = *(const u32x4*)(cp + 64); c2[j] = (u32x4){0u, 0u, 0u, 0u}; c3[j] = c2[j];
                if (isq) { c2[j] = *(const u32x4*)(cp + 128); c3[j] = *(const u32x4*)(cp + 192); }
                const bf16_t* u96 = isq ? wsp<bf16_t>(p, WS_UQ) + row * 384 + h * 96 : wsp<bf16_t>(p, WS_UKV) + row * 512 + h * 128;
                u0[j] = *(const u32x4*)(u96 + ch * 8);
                u1[j] = (u32x4){0u, 0u, 0u, 0u};
                if (tail) u1[j] = isq ? *(const u32x4*)(u96 + 64 + ch * 8) : *(const u32x4*)(P + row * INWP + O_KPE + ch * 8);
                if (!isq) vw[it] = *(const u32x4*)(u96 + 64 + ch * 8);
                rt0[j] = (f32x4){0.f, 0.f, 0.f, 0.f}; rt1[j] = rt0[j];
                if (lat && tail) { const float* tc = wsp<float>(p, WS_TRM) + (size_t)(posl + it) * 32 + ch * 8; rt0[j] = *(const f32x4*)tc; rt1[j] = *(const f32x4*)(tc + 4); } }
            asm volatile("" ::: "memory");
#pragma unroll
            for (int j = 0; j < 4; ++j) { const int it = hb * 4 + j;
                float x[8], cs = 0.f;
                unpk8(c0[j], x);
#pragma unroll
                for (int d = 0; d < 8; ++d) cs += x[d] * x[d];
                unpk8(c1[j], x);
#pragma unroll
                for (int d = 0; d < 8; ++d) cs += x[d] * x[d];
                unpk8(c2[j], x);
#pragma unroll
                for (int d = 0; d < 8; ++d) cs += x[d] * x[d];
                unpk8(c3[j], x);
#pragma unroll
                for (int d = 0; d < 8; ++d) cs += x[d] * x[d];
                const float ss = rsqrtf(sum8(cs) * (isq ? 1.f / 256.f : 1.f / 128.f) + EPS);
                float y0[8], y1[8]; unpk8(u0[j], y0); unpk8(u1[j], y1); const float f1 = isq ? ss : 1.f; float s2 = 0.f;
#pragma unroll
                for (int d = 0; d < 8; ++d) { y0[d] *= ss; y1[d] *= f1; s2 += y0[d] * y0[d] + y1[d] * y1[d]; }
                const float r = rsqrtf(sum8(s2) * (1.f / 96.f) + EPS) * qs;
#pragma unroll
                for (int d = 0; d < 8; ++d) { y0[d] *= r * g0[d]; y1[d] *= r * g1[d]; }
                if (lat && tail) { const f32x4 t0 = rt0[j], t1 = rt1[j];
                    const float a0 = y1[0], a1 = y1[1], b0 = y1[2], b1 = y1[3], e0 = y1[4], e1 = y1[5], d0 = y1[6], d1 = y1[7];
                    y1[0] = a0 * t0[0] - a1 * t0[1]; y1[1] = a0 * t0[1] + a1 * t0[0]; y1[2] = b0 * t0[2] - b1 * t0[3]; y1[3] = b0 * t0[3] + b1 * t0[2];
                    y1[4] = e0 * t1[0] - e1 * t1[1]; y1[5] = e0 * t1[1] + e1 * t1[0]; y1[6] = d0 * t1[2] - d1 * t1[3]; y1[7] = d0 * t1[3] + d1 * t1[2]; }
                *(u32x4*)(dst + (size_t)it * 96) = pk8(y0);
                if (tail) *(u32x4*)(dst + (size_t)it * 96 + 64) = pk8(y1);
                if (!isq) { float v[8]; unpk8(vw[it], v);
#pragma unroll
                    for (int d = 0; d < 8; ++d) v[d] *= ss;
                    vw[it] = pk8(v); } } }
        if (!isq) stT8(wsp<bf16_t>(p, WS_VTM) + ((size_t)(b * 4 + h) * 64 + ch * 8) * KV + posl, vw);
    }
}

DEVI void mm_tile(f32x16& acc, const bf16_t* A, int lda, const bf16_t* Bt, int ldb, int mb, int nb, int lane) {
    const int r32 = lane & 31, hh = lane >> 5;
#pragma unroll
    for (int ks = 0; ks < 4; ++ks) { const bf16x8 a = *(const bf16x8*)(A + (mb * 32 + r32) * lda + ks * 16 + 8 * hh), b = *(const bf16x8*)(Bt + (nb * 32 + r32) * ldb + ks * 16 + 8 * hh);
        acc = __builtin_amdgcn_mfma_f32_32x32x16_bf16(a, b, acc, 0, 0, 0); }
}
DEVI int crow(int reg, int hh) { return (reg & 3) + 8 * (reg >> 2) + 4 * hh; }
DEVI void tile_store_t(const f32x16& acc, bf16_t* dst, int ld, int mb, int nb, int lane) {
    const int r32 = lane & 31, hh = lane >> 5;
#pragma unroll
    for (int g = 0; g < 4; ++g) { u32x2 w; w.x = pk2(acc[4 * g], acc[4 * g + 1]); w.y = pk2(acc[4 * g + 2], acc[4 * g + 3]); *(u32x2*)(dst + (size_t)(nb * 32 + r32) * ld + mb * 32 + 8 * g + 4 * hh) = w; }
}
constexpr size_t DN_ITEM = 4096;

constexpr int DNW_LDS = 64 * 68 * 4 + 4 * 64 * 4;
DEVI int swz(int r, int c8) { return r * 64 + ((c8 ^ (r & 7)) << 3); }
DEVI bf16x8 frag_lds(const bf16_t* M, int row, int ks, int hh) { return *(const bf16x8*)(M + swz(row, ks * 2 + hh)); }
DEVI void tile_store_t_swz(const f32x16& acc, bf16_t* M, int mb, int nb, int lane) {
    const int R = nb * 32 + (lane & 31), hh = lane >> 5;
#pragma unroll
    for (int g = 0; g < 4; ++g) { u32x2 w; w.x = pk2(acc[4 * g], acc[4 * g + 1]); w.y = pk2(acc[4 * g + 2], acc[4 * g + 3]); *(u32x2*)(M + swz(R, mb * 4 + g) + 4 * hh) = w; }
}
DEVI void dn_chunk_wave(const Params& p, char* ldsw, int it, int lane_in) {
    int lane = lane_in; asm volatile("" : "+v"(lane));
    const int r32 = lane & 31, hh = lane >> 5;
    float* AT = (float*)ldsw; bf16_t* R1 = (bf16_t*)ldsw; bf16_t* R2 = R1 + 4096;
    float* gcn = (float*)(ldsw + 64 * 68 * 4); float* be = gcn + 64; float* dec = be + 64; float* eg = dec + 64;
    const int blk = it % NCH, dir = (it / NCH) & 1, bh = it / (NCH * 2), pos0 = blk * 64;
    float egl;
    { const int i = dir ? 63 - lane : lane; const size_t go = ((size_t)(bh * 2 + dir)) * KV + pos0 + i; float g = wsp<float>(p, WS_DG)[go];
#pragma unroll
      for (int o = 1; o < 64; o <<= 1) { const float t = __shfl_up(g, o); if (lane >= o) g += t; }
      const float gl = __shfl(g, 63); gcn[i] = g; be[i] = wsp<float>(p, WS_DBETA)[go]; dec[i] = __expf(gl - g); eg[i] = __expf(g); egl = __expf(gl); }
    bf16x8 kr[2][4];
#pragma unroll
    for (int mb = 0; mb < 2; ++mb)
#pragma unroll
        for (int ks = 0; ks < 4; ++ks) kr[mb][ks] = *(const bf16x8*)(wsp<bf16_t>(p, WS_KD) + ((size_t)bh * KV + pos0 + mb * 32 + r32) * 64 + ks * 16 + 8 * hh);
#pragma unroll
    for (int mb = 0; mb < 2; ++mb)
#pragma unroll
        for (int nb = 0; nb < 2; ++nb) { f32x16 acc;
#pragma unroll
            for (int q = 0; q < 16; ++q) acc[q] = 0.f;
#pragma unroll
            for (int ks = 0; ks < 4; ++ks) acc = __builtin_amdgcn_mfma_f32_32x32x16_bf16(kr[mb][ks], kr[nb][ks], acc, 0, 0, 0);
            const int j = nb * 32 + r32, sj = dir ? 63 - j : j; const float gcj = gcn[j];
#pragma unroll
            for (int q = 0; q < 16; ++q) { const int i = mb * 32 + crow(q, hh), si = dir ? 63 - i : i; AT[sj * 68 + si] = sj < si ? acc[q] * be[i] * __expf(gcn[i] - gcj) : 0.f; } }
    asm volatile("" ::: "memory");
    f32x2_t y2[32];
#pragma unroll
    for (int k = 0; k < 32; ++k) y2[k] = (f32x2_t){0.f, 0.f};
#pragma unroll
    for (int j = 63; j >= 0; --j) {
        unsigned rowoff = (unsigned)(j * 68 * 4); int lj = lane; asm volatile("" : "+v"(rowoff), "+v"(lj) : "v"(y2[j < 63 ? (j + 1) >> 1 : 31]));
        f32x2_t a0 = (f32x2_t){(lj == j) ? 1.f : 0.f, 0.f}, a1 = (f32x2_t){0.f, 0.f};
#pragma unroll
        for (int i = 60; i >= ((j + 1) & ~3); i -= 4) { if (i > 63) continue; const f32x4 a = *(const f32x4*)((const float*)((const char*)AT + rowoff) + i);
            a0 -= y2[i >> 1] * (f32x2_t){a[0], a[1]}; a1 -= y2[(i >> 1) + 1] * (f32x2_t){a[2], a[3]};
            if ((i & 31) == 0) asm volatile("" : "+v"(rowoff) : "v"(a0), "v"(a1)); }
        const float yj = (a0[0] + a0[1]) + (a1[0] + a1[1]);
        if (j & 1) y2[j >> 1][1] = yj; else y2[j >> 1][0] = yj; }
    float y[64];
#pragma unroll
    for (int k = 0; k < 32; ++k) { y[2 * k] = y2[k][0]; y[2 * k + 1] = y2[k][1]; }
    const int inat = dir ? 63 - lane : lane;
#define DN_WRITE_T(WITH_EG) do { _Pragma("unroll") for (int c8 = 0; c8 < 8; ++c8) { float v[8]; \
        _Pragma("unroll") for (int t = 0; t < 8; ++t) { const int j = c8 * 8 + t; const float yy = dir ? y[63 - j] : y[j]; v[t] = yy * be[j] * ((WITH_EG) ? eg[j] : 1.f); } \
        *(u32x4*)(R1 + swz(inat, c8)) = pk8(v); } } while (0)
    DN_WRITE_T(false);
    const size_t mo = (size_t)it * DN_ITEM;
    asm volatile("" ::: "memory");
    bf16x8 vt[2][4];
#pragma unroll
    for (int mb = 0; mb < 2; ++mb)
#pragma unroll
        for (int ks = 0; ks < 4; ++ks) vt[mb][ks] = *(const bf16x8*)(wsp<bf16_t>(p, WS_VTD) + ((size_t)bh * 64 + mb * 32 + r32) * KV + pos0 + ks * 16 + 8 * hh);
#pragma unroll
    for (int mb = 0; mb < 2; ++mb)
#pragma unroll
        for (int nb = 0; nb < 2; ++nb) { f32x16 acc;
#pragma unroll
            for (int q = 0; q < 16; ++q) acc[q] = 0.f;
#pragma unroll
            for (int ks = 0; ks < 4; ++ks) acc = __builtin_amdgcn_mfma_f32_32x32x16_bf16(frag_lds(R1, mb * 32 + r32, ks, hh), vt[nb][ks], acc, 0, 0, 0);
            float* U = wsp<float>(p, WS_DU) + mo + (size_t)(mb * 2 + nb) * 1024;
#pragma unroll
            for (int q = 0; q < 16; ++q) { U[q * 64 + lane] = acc[q]; acc[q] *= dec[mb * 32 + crow(q, hh)]; }
            tile_store_t_swz(acc, R2, mb, nb, lane); }
    DN_WRITE_T(true);
    asm volatile("" ::: "memory");
    bf16x8 kt[2][4];
#pragma unroll
    for (int mb = 0; mb < 2; ++mb)
#pragma unroll
        for (int ks = 0; ks < 4; ++ks) kt[mb][ks] = *(const bf16x8*)(wsp<bf16_t>(p, WS_KTD) + ((size_t)bh * 64 + mb * 32 + r32) * KV + pos0 + ks * 16 + 8 * hh);
#pragma unroll
    for (int mb = 0; mb < 2; ++mb)
#pragma unroll
        for (int nb = 0; nb < 2; ++nb) { f32x16 acc;
#pragma unroll
            for (int q = 0; q < 16; ++q) acc[q] = 0.f;
#pragma unroll
            for (int ks = 0; ks < 4; ++ks) acc = __builtin_amdgcn_mfma_f32_32x32x16_bf16(kt[mb][ks], frag_lds(R2, nb * 32 + r32, ks, hh), acc, 0, 0, 0);
            float* Nn = wsp<float>(p, WS_DN) + mo + (size_t)(mb * 2 + nb) * 1024;
#pragma unroll
            for (int q = 0; q < 16; ++q) Nn[q * 64 + lane] = acc[q]; }
#pragma unroll
    for (int mb = 0; mb < 2; ++mb)
#pragma unroll
        for (int nb = 0; nb < 2; ++nb) { f32x16 acc;
#pragma unroll
            for (int q = 0; q < 16; ++q) acc[q] = 0.f;
#pragma unroll
            for (int ks = 0; ks < 4; ++ks) acc = __builtin_amdgcn_mfma_f32_32x32x16_bf16(frag_lds(R1, mb * 32 + r32, ks, hh), kt[nb][ks], acc, 0, 0, 0);
#pragma unroll
            for (int q = 0; q < 16; ++q) acc[q] *= dec[mb * 32 + crow(q, hh)];
            tile_store_t_swz(acc, R2, mb, nb, lane);
#pragma unroll
            for (int q = 0; q < 16; ++q) acc[q] = 0.f;
#pragma unroll
            for (int ks = 0; ks < 4; ++ks) acc = __builtin_amdgcn_mfma_f32_32x32x16_bf16(kt[mb][ks], frag_lds(R1, nb * 32 + r32, ks, hh), acc, 0, 0, 0);
            tile_store_t(acc, (bf16_t*)(wsp<float>(p, WS_DW) + mo), 64, mb, nb, lane); }
#pragma unroll
    for (int mb = 0; mb < 2; ++mb)
#pragma unroll
        for (int nb = 0; nb < 2; ++nb) { f32x16 acc;
#pragma unroll
            for (int q = 0; q < 16; ++q) acc[q] = 0.f;
#pragma unroll
            for (int ks = 0; ks < 4; ++ks) acc = __builtin_amdgcn_mfma_f32_32x32x16_bf16(frag_lds(R2, mb * 32 + r32, ks, hh), kt[nb][ks], acc, 0, 0, 0);
#pragma unroll
            for (int q = 0; q < 16; ++q) acc[q] = ((mb * 32 + crow(q, hh)) == (nb * 32 + r32) ? egl : 0.f) - acc[q];
            tile_store_t(acc, (bf16_t*)(wsp<float>(p, WS_DM) + mo), 64, mb, nb, lane); }
}
#undef DN_WRITE_T
DEVI void dn_chunk_local(const Params& p, char* lds, int l) {
    const int tid = tid_fresh(), lane = tid & 63, wid = __builtin_amdgcn_readfirstlane(tid >> 6);
    const int NITEM = NB * 4 * 2 * NCH;
    float* gq = (float*)(lds + 8 * DNW_LDS);
    __syncthreads();
    for (int i = tid; i < 192; i += NTHREADS) gq[i] = i < 96 ? p.in[I_MQNG][l * 96 + i] : p.in[I_MKNG][l * 96 + i - 96];
    __syncthreads();
#pragma unroll 1
    for (int it = blockIdx.x * 8 + wid; it < NITEM; it += gridDim.x * 8) dn_chunk_wave(p, lds + wid * DNW_LDS, it, lane);
    mla_rows(p, gq, l, lane);
    __syncthreads();
}

DEVI void dn_scan_wave(const Params& p, char* lds_wave, int item, int lane) {
    const int nb = item & 1, dir = (item >> 1) & 1, bh = item >> 2, r32 = lane & 31, hh = lane >> 5;
    bf16_t* St = (bf16_t*)lds_wave;
    u32x2 pk[2][4];
#pragma unroll
    for (int mb = 0; mb < 2; ++mb)
#pragma unroll
        for (int g = 0; g < 4; ++g) { pk[mb][g] = (u32x2){0u, 0u}; *(u32x2*)(St + r32 * 72 + mb * 32 + 8 * g + 4 * hh) = pk[mb][g]; }
    bf16x8 am[2][4], amn[2][4]; f32x16 nn[2], nnn[2];
    auto blk_of = [&](int step) { return dir ? 67 - step : (step < 4 ? 64 + step : step - 4); };
    auto load = [&](int step, bf16x8 (&a)[2][4], f32x16 (&n)[2]) { const size_t mo = ((size_t)((bh * 2 + dir) * NCH + blk_of(step))) * DN_ITEM;
        const bf16_t* Mm = (const bf16_t*)(wsp<float>(p, WS_DM) + mo); const float* Nn = wsp<float>(p, WS_DN) + mo;
#pragma unroll
        for (int mb = 0; mb < 2; ++mb) {
#pragma unroll
            for (int ks = 0; ks < 4; ++ks) a[mb][ks] = *(const bf16x8*)(Mm + (mb * 32 + r32) * 64 + ks * 16 + 8 * hh);
#pragma unroll
            for (int q = 0; q < 16; ++q) n[mb][q] = Nn[(size_t)(mb * 2 + nb) * 1024 + q * 64 + lane]; } };
    load(0, am, nn);
#pragma unroll 1
    for (int step = 0; step < NCH; ++step) {
        if (step + 1 < NCH) load(step + 1, amn, nnn);
        bf16_t* Sd = (bf16_t*)(wsp<float>(p, WS_DS) + ((size_t)((bh * 2 + dir) * NCH + blk_of(step))) * DN_ITEM);
#pragma unroll
        for (int mb = 0; mb < 2; ++mb)
#pragma unroll
            for (int g = 0; g < 4; ++g) *(u32x2*)(Sd + (size_t)(nb * 32 + r32) * 64 + mb * 32 + 8 * g + 4 * hh) = pk[mb][g];
        bf16x8 bs[4];
#pragma unroll
        for (int ks = 0; ks < 4; ++ks) bs[ks] = *(const bf16x8*)(St + r32 * 72 + ks * 16 + 8 * hh);
#pragma unroll
        for (int mb = 0; mb < 2; ++mb) {
#pragma unroll
            for (int ks = 0; ks < 4; ++ks) nn[mb] = __builtin_amdgcn_mfma_f32_32x32x16_bf16(am[mb][ks], bs[ks], nn[mb], 0, 0, 0);
#pragma unroll
            for (int g = 0; g < 4; ++g) { pk[mb][g].x = pk2(nn[mb][4 * g], nn[mb][4 * g + 1]); pk[mb][g].y = pk2(nn[mb][4 * g + 2], nn[mb][4 * g + 3]);
                *(u32x2*)(St + r32 * 72 + mb * 32 + 8 * g + 4 * hh) = pk[mb][g]; } }
#pragma unroll
        for (int mb = 0; mb < 2; ++mb) {
#pragma unroll
            for (int ks = 0; ks < 4; ++ks) am[mb][ks] = amn[mb][ks];
            nn[mb] = nnn[mb]; }
    }
}

DEVI void dn_output(const Params& p, char* lds, int l) {
    const int tid = tid_fresh(), lane = tid & 63, wid = tid >> 6, r32 = lane & 31, hh = lane >> 5;
    const int dir = wid >> 2, wq = wid & 3, mb = wq >> 1, nb = wq & 1, t256 = tid & 255;
    bf16_t* Qr = (bf16_t*)lds; bf16_t* Kr = Qr + 64 * 72; bf16_t* Dm = Kr + 64 * 72 + dir * 4 * 64 * 72;
    bf16_t* Wr = Dm; bf16_t* St = Dm + 64 * 72; bf16_t* At = St + 64 * 72; bf16_t* Vn = At + 64 * 72;
    float* oS = (float*)(Qr + 10 * 64 * 72); float* gcn = oS + 64 * 65 + dir * 64;
    const int NITEM = NB * 4 * NCH;
    const float gdo = p.in[I_DOUTG][l * 64 + lane];
    for (int it = blockIdx.x; it < NITEM; it += gridDim.x) {
        const int blk = it % NCH, bh = it / NCH, b = bh >> 2, h = bh & 3, pos0 = blk * 64;
        if (l == 1 && blk >= 64) continue;
        const size_t mo = ((size_t)((bh * 2 + dir) * NCH + blk)) * DN_ITEM;
        __syncthreads();
        unsigned short gtv[8]; float gdg = 0.f; float uu[16];
        { const int rr = tid >> 3, cc = (tid & 7) * 8;
          const u32x4 gq = *(const u32x4*)(wsp<bf16_t>(p, WS_QD) + ((size_t)bh * KV + pos0) * 64 + tid * 8), gk = *(const u32x4*)(wsp<bf16_t>(p, WS_KD) + ((size_t)bh * KV + pos0) * 64 + tid * 8);
          u32x4 gw[2], gs[2];
#pragma unroll
          for (int q = 0; q < 2; ++q) { const int ci = t256 + q * 256; gw[q] = *(const u32x4*)((const bf16_t*)(wsp<float>(p, WS_DW) + mo) + ci * 8); gs[q] = *(const u32x4*)((const bf16_t*)(wsp<float>(p, WS_DS) + mo) + ci * 8); }
#pragma unroll
          for (int k = 0; k < 8; ++k) gtv[k] = *(const unsigned short*)(wsp<bf16_t>(p, WS_P) + (size_t)bp2row(b, pos0 + wid + 8 * k) * INWP + O_DG + h * 64 + lane);
          if (wq == 0) gdg = wsp<float>(p, WS_DG)[((size_t)(bh * 2 + dir)) * KV + pos0 + (dir ? 63 - lane : lane)];
          { const float* U = wsp<float>(p, WS_DU) + mo + (size_t)(mb * 2 + nb) * 1024;
#pragma unroll
            for (int q = 0; q < 16; ++q) uu[q] = U[q * 64 + lane]; }
          asm volatile("" ::: "memory");
          *(u32x4*)(Qr + rr * 72 + cc) = gq; *(u32x4*)(Kr + rr * 72 + cc) = gk;
#pragma unroll
          for (int q = 0; q < 2; ++q) { const int ci = t256 + q * 256, r2 = ci >> 3, c2 = (ci & 7) * 8; *(u32x4*)(Wr + r2 * 72 + c2) = gw[q]; *(u32x4*)(St + r2 * 72 + c2) = gs[q]; } }
        if (wq == 0) { const int i = dir ? 63 - lane : lane; float g = gdg;
#pragma unroll
            for (int oo = 1; oo < 64; oo <<= 1) { const float t = __shfl_up(g, oo); if (lane >= oo) g += t; }
            gcn[i] = g; }
        __syncthreads();
        {
            f32x16 acc;
#pragma unroll
            for (int q = 0; q < 16; ++q) acc[q] = 0.f;
            mm_tile(acc, Kr, 72, Qr, 72, mb, nb, lane);
            const int i = nb * 32 + r32; const float gci = gcn[i];
#pragma unroll
            for (int q = 0; q < 16; ++q) { const int j = mb * 32 + crow(q, hh); const bool ok = dir ? (j >= i) : (j <= i); acc[q] = ok ? acc[q] * __expf(gci - gcn[j]) : 0.f; }
            tile_store_t(acc, At, 72, mb, nb, lane);
#pragma unroll
            for (int q = 0; q < 16; ++q) acc[q] = 0.f;
            mm_tile(acc, Wr, 72, St, 72, mb, nb, lane);
#pragma unroll
            for (int q = 0; q < 16; ++q) acc[q] = uu[q] - acc[q];
            tile_store_t(acc, Vn, 72, mb, nb, lane); }
        __syncthreads();
        f32x16 o;
        {
            f32x16 t;
#pragma unroll
            for (int q = 0; q < 16; ++q) t[q] = 0.f;
            mm_tile(t, Qr, 72, St, 72, mb, nb, lane);
#pragma unroll
            for (int q = 0; q < 16; ++q) o[q] = t[q] * __expf(gcn[mb * 32 + crow(q, hh)]);
            mm_tile(o, At, 72, Vn, 72, mb, nb, lane); }
        if (dir == 0) {
#pragma unroll
            for (int q = 0; q < 16; ++q) oS[(mb * 32 + crow(q, hh)) * 65 + nb * 32 + r32] = o[q]; }
        __syncthreads();
        if (dir == 1) {
#pragma unroll
            for (int q = 0; q < 16; ++q) oS[(mb * 32 + crow(q, hh)) * 65 + nb * 32 + r32] += o[q]; }
        __syncthreads();
        { float v[8];
#pragma unroll
          for (int k = 0; k < 8; ++k) v[k] = oS[(wid + 8 * k) * 65 + lane];
#pragma unroll
          for (int k = 0; k < 8; ++k) { const int row = bp2row(b, pos0 + wid + 8 * k); const float ss = wave_sum(v[k] * v[k]);
              const float gate = __builtin_bit_cast(float, (unsigned)gtv[k] << 16);
              wsp<unsigned char>(p, WS_Y)[(size_t)row * D + 512 + h * 64 + lane] = (unsigned char)(__builtin_amdgcn_cvt_pk_fp8_f32(clamp8(v[k] * rsqrtf(ss * (1.f / 64.f) + EPS) * gdo * siluf(gate) * S8_ACT), 0.f, 0, false) & 0xff); } }
    }
}

template <int DK> struct AttnW { bf16x8 qf[DK / 16]; f32x16 o[2]; f32x16 negm; float l; };
struct NoAdj { DEVI void operator()(f32x16 (&)[2], int) const {} };
DEVI bf16x8 pack8(float a, float b, float c, float d, float e, float f, float g, float h) { u32x4 w; w.x = pk2(a, b); w.y = pk2(c, d); w.z = pk2(e, f); w.w = pk2(g, h); return __builtin_bit_cast(bf16x8, w); }
DEVI float max3f(float a, float b, float c) { float r; asm("v_max3_f32 %0, %1, %2, %3" : "=v"(r) : "v"(a), "v"(b), "v"(c)); return r; }

template <int DK, int VS, class Adj> DEVI void attn_tile(AttnW<DK>& w, const bf16_t* Ks, const bf16_t* Vts, int lane, const Adj& adj) {
    const int r32 = lane & 31, hh = lane >> 5;
    f32x16 s[2];
#pragma unroll
    for (int kb = 0; kb < 2; ++kb) {
        s[kb] = w.negm;
#pragma unroll
        for (int ks = 0; ks < DK / 16; ++ks) { const bf16x8 kf = *(const bf16x8*)(Ks + (kb * 32 + r32) * (DK + 8) + ks * 16 + 8 * hh);
            s[kb] = __builtin_amdgcn_mfma_f32_32x32x16_bf16(kf, w.qf[ks], s[kb], 0, 0, 0); } }
    adj(s, lane);
#pragma unroll
    for (int kb = 0; kb < 2; ++kb) {
        float mx = max3f(s[kb][0], s[kb][1], s[kb][2]);
#pragma unroll
        for (int i = 3; i < 15; i += 2) mx = max3f(mx, s[kb][i], s[kb][i + 1]);
        mx = fmaxf(mx, s[kb][15]);
        if (!__all(mx <= 8.f)) {
            mx = fmaxf(mx, __shfl_xor(mx, 32));
            const float up = fmaxf(mx, 0.f), alpha = __builtin_amdgcn_exp2f(-up); w.l *= alpha;
#pragma unroll
            for (int i = 0; i < 16; ++i) { w.o[0][i] *= alpha; w.o[1][i] *= alpha; w.negm[i] -= up; s[kb][i] -= up; if (kb == 0) s[1][i] -= up; } }
        float rs = 0.f;
#pragma unroll
        for (int i = 0; i < 16; ++i) { const float pv = __builtin_amdgcn_exp2f(s[kb][i]); s[kb][i] = pv; rs += pv; }
        w.l += rs;
#pragma unroll
        for (int s2 = 0; s2 < 2; ++s2) { const int b8 = 8 * s2;
            const bf16x8 pf = pack8(s[kb][b8], s[kb][b8 + 1], s[kb][b8 + 2], s[kb][b8 + 3], s[kb][b8 + 4], s[kb][b8 + 5], s[kb][b8 + 6], s[kb][b8 + 7]);
#pragma unroll
            for (int db = 0; db < 2; ++db) { const bf16_t* vp = Vts + (db * 32 + r32) * VS + kb * 32 + 16 * s2 + 4 * hh;
                const u32x2 lo = *(const u32x2*)vp, hi = *(const u32x2*)(vp + 8); u32x4 vv; vv.x = lo.x; vv.y = lo.y; vv.z = hi.x; vv.w = hi.y;
                w.o[db] = __builtin_amdgcn_mfma_f32_32x32x16_bf16(__builtin_bit_cast(bf16x8, vv), pf, w.o[db], 0, 0, 0); } }
    }
}
template <int DK> DEVI void attn_init(AttnW<DK>& w, const bf16_t* qrow, int lane) {
#pragma unroll
    for (int ks = 0; ks < DK / 16; ++ks) w.qf[ks] = *(const bf16x8*)(qrow + ks * 16 + 8 * (lane >> 5));
#pragma unroll
    for (int i = 0; i < 16; ++i) { w.o[0][i] = 0.f; w.o[1][i] = 0.f; w.negm[i] = 0.f; }
    w.l = 0.f;
}
template <int DK> DEVI void attn_finish(AttnW<DK>& w, unsigned char* yrow  , int lane) {
    const float lt = w.l + __shfl_xor(w.l, 32), inv = 1.f / lt; const int hh = lane >> 5;
#pragma unroll
    for (int db = 0; db < 2; ++db)
#pragma unroll
        for (int g = 0; g < 4; ++g) { const float sc = inv * S8_ACT;
            *(unsigned*)(yrow + db * 32 + 8 * g + 4 * hh) = pk4_fp8(w.o[db][4 * g] * sc, w.o[db][4 * g + 1] * sc, w.o[db][4 * g + 2] * sc, w.o[db][4 * g + 3] * sc); }
}

template <int DK> DEVI void attn_dense_unit(char* lds, const bf16_t* Q  , const bf16_t* Kh  , const bf16_t* Vth  ,
                                            int qpos0, int tile0, int ntiles, unsigned char* y0  ) {
    const int tid = tid_fresh(), lane = tid & 63, wid = tid >> 6;
    constexpr int KCH = 128 * DK / 8, NKC = KCH / 512;
    constexpr int VS = 132, BUF = 128 * (DK + 8) + 64 * VS;
    bf16_t* base = (bf16_t*)lds;
    AttnW<DK> w; attn_init(w, Q + (size_t)(qpos0 + wid * 32 + (lane & 31)) * DK, lane);
    const int nst = ntiles >> 1;
    u32x4 rk[NKC], rv[2];
    auto prefetch = [&](int st) { const bf16_t* kt = Kh + (size_t)(tile0 + 2 * st) * 64 * DK;
#pragma unroll
        for (int q = 0; q < NKC; ++q) rk[q] = *(const u32x4*)(kt + (q * 512 + tid) * 8);
#pragma unroll
        for (int q = 0; q < 2; ++q) { const int ci = q * 512 + tid; rv[q] = *(const u32x4*)(Vth + (size_t)(ci >> 4) * KV + (tile0 + 2 * st) * 64 + (ci & 15) * 8); } };
    auto stage = [&](int bsel) { bf16_t* Ks = base + bsel * BUF; bf16_t* Vts = Ks + 128 * (DK + 8);
#pragma unroll
        for (int q = 0; q < NKC; ++q) { const int ci = q * 512 + tid, key = ci / (DK / 8), c = ci % (DK / 8); *(u32x4*)(Ks + key * (DK + 8) + c * 8) = rk[q]; }
#pragma unroll
        for (int q = 0; q < 2; ++q) { const int ci = q * 512 + tid; bf16_t* vd = Vts + (ci >> 4) * VS + (ci & 15) * 8; u32x2 a, b; a.x = rv[q].x; a.y = rv[q].y; b.x = rv[q].z; b.y = rv[q].w; *(u32x2*)vd = a; *(u32x2*)(vd + 4) = b; } };
    prefetch(0);
    __syncthreads();
    stage(0);
    if (nst > 1) prefetch(1);
    __syncthreads();
#pragma unroll 1
    for (int st = 0; st < nst; ++st) {
        if (st + 1 < nst) stage((st + 1) & 1);
        if (st + 2 < nst) prefetch(st + 2);
        const bf16_t* Ks = base + (st & 1) * BUF; const bf16_t* Vts = Ks + 128 * (DK + 8);
        attn_tile<DK, VS>(w, Ks, Vts, lane, NoAdj());
        attn_tile<DK, VS>(w, Ks + 64 * (DK + 8), Vts + 64, lane, NoAdj());
        __syncthreads();
    }
    attn_finish<DK>(w, y0 + (size_t)(wid * 32 + (lane & 31)) * D, lane);
}

struct NaAdj { const float* bias;   int c0;
    DEVI void operator()(f32x16 (&s)[2], int lane) const { const int hh = lane >> 5;
#pragma unroll
        for (int kb = 0; kb < 2; ++kb)
#pragma unroll
            for (int i = 0; i < 16; ++i) { const int wl = kb * 32 + (i & 3) + 8 * (i >> 2); const int wk = wl + 4 * hh; const bool ok = wk >= c0 && wk < c0 + 16;
                s[kb][i] = ok ? s[kb][i] + bias[wl] : -1e30f; } } };
DEVI void attn_na_unit(const Params& p, char* lds, int l, int b, int h, int rg) {
    const int tid = tid_fresh(), lane = tid & 63, wid = tid >> 6;
    constexpr int BUF = 64 * 72 + 64 * 68;
    bf16_t* base = (bf16_t*)lds; float* bias = (float*)(base + 2 * BUF);
    const int r = rg * 4 + (wid >> 1), cq = (wid & 1) * 32 + (lane & 31), r0 = min(max(r - 4, 0), GW - 8);
    const int rlo = min(max(rg * 4 - 4, 0), GW - 8), rhi = min(max(rg * 4 + 3 - 4, 0), GW - 8) + 7, nl = rhi - rlo + 1, ntiles = nl + 4;
    const bf16_t* Kh = wsp<bf16_t>(p, WS_KNA) + (size_t)(b * 4 + h) * KV * 64; const bf16_t* Vth = wsp<bf16_t>(p, WS_VTNA) + (size_t)(b * 4 + h) * 64 * KV;
    AttnW<64> w; attn_init(w, wsp<bf16_t>(p, WS_QNA) + ((size_t)(b * 4 + h) * KV + r * 64 + cq) * 64, lane);
    u32x4 rk0, rv;
    auto key0 = [&](int t) { return t < nl ? (rlo + t) * 64 : SEQ + (t - nl) * 64; };
    auto prefetch = [&](int t) { const int k0 = key0(t); rk0 = *(const u32x4*)(Kh + (size_t)k0 * 64 + tid * 8); rv = *(const u32x4*)(Vth + (size_t)(tid >> 3) * KV + k0 + (tid & 7) * 8); };
    auto stage = [&](int bsel) { bf16_t* Ks = base + bsel * BUF; bf16_t* Vts = Ks + 64 * 72; *(u32x4*)(Ks + (tid >> 3) * 72 + (tid & 7) * 8) = rk0;
        bf16_t* vd = Vts + (tid >> 3) * 68 + (tid & 7) * 8; u32x2 a, c; a.x = rv.x; a.y = rv.y; c.x = rv.z; c.y = rv.w; *(u32x2*)vd = a; *(u32x2*)(vd + 4) = c; };
    prefetch(0);
    __syncthreads();
    for (int i = tid; i < 15 * 31; i += NTHREADS) bias[i] = p.in[I_NABIAS][((size_t)l * 4 + h) * 15 * 31 + i] * LOG2E;
    stage(0);
    prefetch(1);
    __syncthreads();
#pragma unroll 1
    for (int t = 0; t < ntiles; ++t) {
        if (t + 1 < ntiles) stage((t + 1) & 1);
        if (t + 2 < ntiles) prefetch(t + 2);
        const bf16_t* Ks = base + (t & 1) * BUF;
        if (t < nl) { const int rr = rlo + t;
            if (rr >= r0 && rr < r0 + 8) { NaAdj adj{bias + (rr - r + 7) * 31 + 15 - cq + 4 * (lane >> 5), min(max(cq - 8, 0), GW - 16)}; attn_tile<64, 68>(w, Ks, Ks + 64 * 72, lane, adj); } }
        else attn_tile<64, 68>(w, Ks, Ks + 64 * 72, lane, NoAdj());
        __syncthreads();
    }
    attn_finish<64>(w, wsp<unsigned char>(p, WS_Y) + (size_t)(b * SEQ + r * 64 + cq) * D + h * 64, lane);
}

#ifndef MIX_DUP
#define MIX_DUP 0
#endif
DEVI void ph_mix(const Params& p, char* lds, int l) {
    { const int tid0 = tid_fresh(), wv = tid0 >> 6; const int first = (int)gridDim.x >= 32 ? (int)gridDim.x - 16 : 0;
      for (int rep = 0; rep < ((MIX_DUP & 8) ? 2 : 1); ++rep)
      for (int wg = (int)blockIdx.x - first; wg >= 0 && wg < 16; wg += gridDim.x) dn_scan_wave(p, lds + wv * 4608, wg * 8 + wv, tid0 & 63); }
    __syncthreads();
    const int per_b = l == 0 ? 204 : 192;
    unsigned char* Y = wsp<unsigned char>(p, WS_Y);
    int* slot = (int*)(lds + 143360);
    unsigned* qctl = wsp<unsigned>(p, WS_CTL) + CW_Q + l * 8 * 64;
    for (int qq = 0; qq < 8; ++qq) {
        const int b = (int)((blockIdx.x + qq) & 7);
        for (;;) {
            __syncthreads();
            if (tid_fresh() == 0) *slot = (int)atomicAdd(qctl + b * 64, 1u);
            __syncthreads();
            const int u = __builtin_amdgcn_readfirstlane(*slot);
            if (u >= per_b * (MIX_DUP ? 2 : 1)) break;
            int v = u % per_b;
            if (MIX_DUP && u >= per_b) { const int kbit = v < 64 ? 2 : v < 128 ? 1 : v < 192 ? 4 : 0; if (!(MIX_DUP & kbit)) continue; }
            if (v >= 128 && v < 192) { attn_na_unit(p, lds, l, b, (v - 128) >> 4, (v - 128) & 15); continue; }
            int kind, h, qpos0, tile0, ntiles; size_t yrow;
            if (v < 64) { kind = 2; h = v >> 4; qpos0 = (v & 15) * 256; tile0 = 0; ntiles = NCH; yrow = (size_t)b * SEQ + qpos0; }
            else if (v < 128) { kind = 1; h = (v - 64) >> 4; qpos0 = (v & 15) * 256; tile0 = 0; ntiles = NCH; yrow = (size_t)b * SEQ + qpos0; }
            else { const int c = v - 192; kind = c >> 2; h = c & 3; qpos0 = SEQ; tile0 = SEQ / 64; ntiles = 4; yrow = (size_t)NLAT + b * CTX; }
            if (kind == 2) attn_dense_unit<96>(lds, wsp<bf16_t>(p, WS_QM) + (size_t)(b * 4 + h) * KV * 96, wsp<bf16_t>(p, WS_KM) + (size_t)(b * 4 + h) * KV * 96,
                                               wsp<bf16_t>(p, WS_VTM) + (size_t)(b * 4 + h) * 64 * KV, qpos0, tile0, ntiles, Y + yrow * D + 768 + h * 64);
            else { const int kvh = kind == 0 ? b * 4 + h : b * 2 + (h >> 1);
                attn_dense_unit<64>(lds, wsp<bf16_t>(p, kind == 0 ? WS_QNA : WS_QG) + (size_t)(b * 4 + h) * KV * 64, wsp<bf16_t>(p, kind == 0 ? WS_KNA : WS_KG) + (size_t)kvh * KV * 64,
                                    wsp<bf16_t>(p, kind == 0 ? WS_VTNA : WS_VTG) + (size_t)kvh * 64 * KV, qpos0, tile0, ntiles, Y + yrow * D + (kind == 0 ? 0 : 256) + h * 64); }
        }
    }
}

DEVI void ph_router(const Params& p, char* lds, int l) {
    const int tid = tid_fresh(), lane = tid & 63, wid = tid >> 6;
    constexpr int RWS = 1028;
    float* rwT = (float*)lds;
    float* hs = (float*)(lds + 32 * RWS * 4) + wid * 512;
    int* lcnt = (int*)(lds + 32 * RWS * 4 + 16384);
    int* sel = wsp<int>(p, WS_SEL);
    const int Mr = l == 0 ? MROWS : NLAT;
    const int per = (((Mr + gridDim.x - 1) / gridDim.x) + 1) & ~1, row_lo = min((int)blockIdx.x * per, Mr), row_hi = min(row_lo + per, Mr);
    __syncthreads();
    for (int i = tid; i < 1024 * 32; i += NTHREADS) rwT[(i & 31) * RWS + (i >> 5)] = p.in[I_RW][(size_t)l * 1024 * 32 + i];
    if (tid < 32) lcnt[tid] = 0;
    __syncthreads();
    const int e = lane & 31, kh = lane >> 5; const float rb = p.in[I_RB][l * 32 + e];
    const float* g2 = p.in[I_N2G] + l * D;
    u32x2 xn[2][4];
    auto fetch = [&](int row) {
#pragma unroll
        for (int rr = 0; rr < 2; ++rr)
#pragma unroll
            for (int i = 0; i < 4; ++i) xn[rr][i] = *(const u32x2*)(wsp<bf16_t>(p, WS_XCUR) + (size_t)(row + rr) * D + i * 256 + lane * 4); };
    f32x4 shv[4], scv[4]; int curb = -1;
#pragma unroll
    for (int i = 0; i < 4; ++i) { shv[i] = (f32x4){0.f, 0.f, 0.f, 0.f}; scv[i] = (f32x4){0.f, 0.f, 0.f, 0.f}; }
    if (row_lo + 2 * wid < row_hi) fetch(row_lo + 2 * wid);
    for (int row = row_lo + 2 * wid; row < row_hi; row += 16) {
        f32x4 v[2][4]; float r[2];
#pragma unroll
        for (int rr = 0; rr < 2; ++rr) { float ss = 0.f;
#pragma unroll
            for (int i = 0; i < 4; ++i) { v[rr][i] = (f32x4){__builtin_bit_cast(float, xn[rr][i].x << 16), __builtin_bit_cast(float, xn[rr][i].x & 0xffff0000u), __builtin_bit_cast(float, xn[rr][i].y << 16), __builtin_bit_cast(float, xn[rr][i].y & 0xffff0000u)};
                ss += v[rr][i][0] * v[rr][i][0] + v[rr][i][1] * v[rr][i][1] + v[rr][i][2] * v[rr][i][2] + v[rr][i][3] * v[rr][i][3]; }
            r[rr] = rsqrtf(wave_sum(ss) * (1.f / 1024.f) + EPS); }
        { const int bt = row < NLAT ? (row >> 12) : 8;
          if (bt != curb) { curb = bt; const float* sh = mod_vec(p, l, row, 3); const float* sc = mod_vec(p, l, row, 4);
#pragma unroll
              for (int i = 0; i < 4; ++i) { shv[i] = *(const f32x4*)(sh + i * 256 + lane * 4); scv[i] = *(const f32x4*)(g2 + i * 256 + lane * 4) * (*(const f32x4*)(sc + i * 256 + lane * 4) + 1.f); } } }
        if (row + 16 < row_hi) fetch(row + 16);
        asm volatile("" ::: "memory");
        float acc[2][2] = {{0.f, 0.f}, {0.f, 0.f}};
#pragma unroll
        for (int i = 0; i < 4; ++i) {
            const int c = i * 256 + lane * 4; const f32x4 s4 = shv[i], c4 = scv[i];
#pragma unroll
            for (int rr = 0; rr < 2; ++rr) { f32x4 y;
#pragma unroll
                for (int j = 0; j < 4; ++j) y[j] = (v[rr][i][j] * r[rr]) * c4[j] + s4[j];
                *(unsigned*)(wsp<unsigned char>(p, WS_HB) + (size_t)(row + rr) * D + c) = pk4_fp8(y[0] * S8_ACT, y[1] * S8_ACT, y[2] * S8_ACT, y[3] * S8_ACT);
                *(f32x4*)(hs + rr * 256 + lane * 4) = y; }
            const float* w0 = rwT + (lane & 15) * RWS + i * 256 + (lane >> 4) * 64; const float* w1 = w0 + 16 * RWS; const float* hq = hs + (lane >> 4) * 64;
#pragma unroll 4
            for (int k4 = 0; k4 < 16; ++k4) { const f32x4 a4 = *(const f32x4*)(w0 + k4 * 4), b4 = *(const f32x4*)(w1 + k4 * 4), h0 = *(const f32x4*)(hq + k4 * 4), h1 = *(const f32x4*)(hq + 256 + k4 * 4);
                acc[0][0] += h0[0] * a4[0] + h0[1] * a4[1] + h0[2] * a4[2] + h0[3] * a4[3]; acc[0][1] += h1[0] * a4[0] + h1[1] * a4[1] + h1[2] * a4[2] + h1[3] * a4[3];
                acc[1][0] += h0[0] * b4[0] + h0[1] * b4[1] + h0[2] * b4[2] + h0[3] * b4[3]; acc[1][1] += h1[0] * b4[0] + h1[1] * b4[1] + h1[2] * b4[2] + h1[3] * b4[3]; }
        }
#pragma unroll
        for (int j = 0; j < 2; ++j)
#pragma unroll
            for (int rr = 0; rr < 2; ++rr) { float t = acc[j][rr];
                { const unsigned u = __builtin_bit_cast(unsigned, t); const auto r = __builtin_amdgcn_permlane16_swap(u, u, false, false); t = __builtin_bit_cast(float, (unsigned)r[0]) + __builtin_bit_cast(float, (unsigned)r[1]); }
                { const unsigned u = __builtin_bit_cast(unsigned, t); const auto r = __builtin_amdgcn_permlane32_swap(u, u, false, false); t = __builtin_bit_cast(float, (unsigned)r[0]) + __builtin_bit_cast(float, (unsigned)r[1]); }
                acc[j][rr] = t; }
#pragma unroll
        for (int rr = 0; rr < 2; ++rr) { const float v0 = __shfl(acc[0][rr], e & 15), v1 = __shfl(acc[1][rr], e & 15); float a = ((e >> 4) ? v1 : v0) + rb;
            unsigned u = __builtin_bit_cast(unsigned, a); u = (u & 0x80000000u) ? ~u : (u | 0x80000000u);
            unsigned key = (u & ~31u) | (unsigned)(31 - e);
            float tv[4]; int ti[4];
#pragma unroll
            for (int k = 0; k < 4; ++k) { unsigned best;
                { int x = (int)key; unsigned t;
                  t = (unsigned)__builtin_amdgcn_update_dpp(0, x, 0xB1, 0xF, 0xF, true); x = (int)((unsigned)x > t ? (unsigned)x : t);
                  t = (unsigned)__builtin_amdgcn_update_dpp(0, x, 0x4E, 0xF, 0xF, true); x = (int)((unsigned)x > t ? (unsigned)x : t);
                  t = (unsigned)__builtin_amdgcn_update_dpp(0, x, 0x141, 0xF, 0xF, true); x = (int)((unsigned)x > t ? (unsigned)x : t);
                  t = (unsigned)__builtin_amdgcn_update_dpp(0, x, 0x140, 0xF, 0xF, true); x = (int)((unsigned)x > t ? (unsigned)x : t);
                  const unsigned r0 = (unsigned)__builtin_amdgcn_readlane(x, 0), r1 = (unsigned)__builtin_amdgcn_readlane(x, 16); best = r0 > r1 ? r0 : r1; }
                ti[k] = 31 - (int)(best & 31u); unsigned ub = best & ~31u; ub = (ub & 0x80000000u) ? (ub & 0x7fffffffu) : ~ub; tv[k] = __builtin_bit_cast(float, ub);
                if (e == ti[k]) key = 0u; }
            const float e1 = __expf(tv[1] - tv[0]), e2 = __expf(tv[2] - tv[0]), e3 = __expf(tv[3] - tv[0]), inv = 1.f / (1.f + e1 + e2 + e3);
            if (lane == 0) { const float gt[4] = {inv, e1 * inv, e2 * inv, e3 * inv};
#pragma unroll
                for (int k = 0; k < 4; ++k) { wsp<float>(p, WS_GATE)[(size_t)(row + rr) * 4 + k] = gt[k]; const int lp = atomicAdd(&lcnt[ti[k]], 1); sel[(size_t)(row + rr) * 4 + k] = ti[k] | (lp << 8); } } }
    }
    __syncthreads();
    if (tid < 32) { const int c = lcnt[tid]; lcnt[tid] = c ? (int)atomicAdd(wsp<unsigned>(p, WS_CTL) + CW_CNT + l * 64 + tid, (unsigned)c) : 0; }
    __syncthreads();
    asm volatile("s_waitcnt vmcnt(0)" ::: "memory");
    __syncthreads();
    for (int i = tid; i < (row_hi - row_lo) * 4; i += NTHREADS) { const int s = sel[(size_t)row_lo * 4 + i], ex = s & 255, lp = s >> 8; wsp<int>(p, WS_LIST)[(size_t)ex * MROWS + lcnt[ex] + lp] = (row_lo + (i >> 2)) * 4 + (i & 3); }
}

#ifndef MOE_ALIGN
#define MOE_ALIGN true
#endif
template <int WHICH> DEVI void ph_moe_gemm(const Params& p, char* lds, int l) {
    int* pre = (int*)(lds + pg8::STAGE_BYTES);
    const unsigned* cnt = wsp<unsigned>(p, WS_CTL) + CW_CNT + l * 64;
    __syncthreads();
    if (tid_fresh() == 0) { int s = 0; for (int e = 0; e < NEXP; ++e) { pre[e] = s; s += ((int)cnt[e] + 255) >> 8; } pre[NEXP] = s; }
    __syncthreads();
    pg8::MoeSched S; S.pre = pre; S.cnt = cnt; S.list = wsp<int>(p, WS_LIST); S.NT = WHICH == 1 ? 8 : 4; S.total = __builtin_amdgcn_readfirstlane(pre[NEXP]) * S.NT; S.G = gridDim.x; S.c = blockIdx.x; S.rshift = 2;
    if (WHICH == 1) { S.A = (const char*)wsp<unsigned char>(p, WS_HB); S.lda_b = D; S.B = (const char*)(wsp<unsigned char>(p, WS_W1) + (size_t)l * NEXP * 2048 * D); S.ldb_b = D; S.estride_b = (size_t)2048 * D; S.gather = true;
        Epi2H E{wsp<unsigned char>(p, WS_H), p.in[I_B1] + (size_t)l * NEXP * 2048};
        pg8::gemm_phase<true, MOE_ALIGN>((LAS unsigned char*)(LAS char*)lds, D, S, E); }
    else { S.A = (const char*)wsp<unsigned char>(p, WS_H); S.lda_b = DEXP; S.B = (const char*)(wsp<unsigned char>(p, WS_W2) + (size_t)l * NEXP * D * DEXP); S.ldb_b = DEXP; S.estride_b = (size_t)D * DEXP; S.gather = false;
        Epi2Y E{wsp<unsigned char>(p, WS_YEXP), p.in[I_B2] + (size_t)l * NEXP * D, wsp<int>(p, WS_LIST), pre};
        pg8::gemm_phase<true, MOE_ALIGN>((LAS unsigned char*)(LAS char*)lds, DEXP, S, E); }
}

DEVI void ph_combine(const Params& p, int l) {
    const int tid = tid_fresh(), lane = tid & 63, gw = blockIdx.x * 8 + (tid >> 6), nw = gridDim.x * 8; const int Mr = l == 0 ? MROWS : NLAT;
    for (int row0 = gw * 2; row0 < Mr; row0 += nw * 2) {
        f32x4 xo[2][4];
#pragma unroll
        for (int rr = 0; rr < 2; ++rr) { const int row = row0 + rr;
            const bf16_t* x = wsp<bf16_t>(p, WS_XCUR) + (size_t)row * D; const float* g5 = mod_vec(p, l, row, 5); const float* gt = wsp<float>(p, WS_GATE) + (size_t)row * 4;
            const unsigned char* ye = wsp<unsigned char>(p, WS_YEXP) + (size_t)row * 4 * D; const f32x4 gg = *(const f32x4*)gt * (1.f / S8_Y);
#pragma unroll
            for (int i = 0; i < 4; ++i) { const int c = i * 256 + lane * 4; f32x4 f = (f32x4){0.f, 0.f, 0.f, 0.f};
#pragma unroll
                for (int k = 0; k < 4; ++k) { const int w = *(const int*)(ye + (size_t)k * D + c); const float g = gg[k];
                    const f32x2_t lo = __builtin_amdgcn_cvt_pk_f32_fp8(w, false), hi = __builtin_amdgcn_cvt_pk_f32_fp8(w, true);
                    f[0] += g * lo[0]; f[1] += g * lo[1]; f[2] += g * hi[0]; f[3] += g * hi[1]; }
                const u32x2 xw = *(const u32x2*)(x + c); const f32x4 xv = (f32x4){__builtin_bit_cast(float, xw.x << 16), __builtin_bit_cast(float, xw.x & 0xffff0000u), __builtin_bit_cast(float, xw.y << 16), __builtin_bit_cast(float, xw.y & 0xffff0000u)};
                xo[rr][i] = xv + *(const f32x4*)(g5 + c) * f; } }
#pragma unroll
        for (int rr = 0; rr < 2; ++rr) { const int row = row0 + rr;
#pragma unroll
            for (int i = 0; i < 4; ++i) { if (l == 0) { u32x2 w; w.x = pk2(xo[rr][i][0], xo[rr][i][1]); w.y = pk2(xo[rr][i][2], xo[rr][i][3]); *(u32x2*)(wsp<bf16_t>(p, WS_XCUR) + (size_t)row * D + i * 256 + lane * 4) = w; }
                else *(f32x4*)(p.out + (size_t)row * D + i * 256 + lane * 4) = xo[rr][i]; }
            if (l == 0) {
                float ss = 0.f;
#pragma unroll
                for (int i = 0; i < 4; ++i) ss += xo[rr][i][0] * xo[rr][i][0] + xo[rr][i][1] * xo[rr][i][1] + xo[rr][i][2] * xo[rr][i][2] + xo[rr][i][3] * xo[rr][i][3];
                ss = wave_sum(ss); const float r = rsqrtf(ss * (1.f / 1024.f) + EPS);
                const float* g = p.in[I_N1G] + D; const float* sh = mod_vec(p, 1, row, 0); const float* sc = mod_vec(p, 1, row, 1); unsigned char* out = wsp<unsigned char>(p, WS_HB) + (size_t)row * D;
#pragma unroll
                for (int i = 0; i < 4; ++i) { const int c = i * 256 + lane * 4; const f32x4 gg = *(const f32x4*)(g + c), s4 = *(const f32x4*)(sh + c), c4 = *(const f32x4*)(sc + c); float y[4];
#pragma unroll
                    for (int j = 0; j < 4; ++j) y[j] = (xo[rr][i][j] * r * gg[j]) * (1.f + c4[j]) + s4[j];
                    *(unsigned*)(out + c) = pk4_fp8(y[0] * S8_ACT, y[1] * S8_ACT, y[2] * S8_ACT, y[3] * S8_ACT); } } }
    }
}

constexpr int N_PHASES = 22;
template <int PH> DEVI void run_phase(const Params& p, char* lds) {
    if constexpr (PH == 0) ph_prologue(p, lds);
    else if constexpr (PH == 1) ph_norm1_l0(p);
    else { constexpr int l = (PH - 2) / 10, q = (PH - 2) % 10;
        if constexpr (q == 0) ph_inproj(p, lds, l);
        else if constexpr (q == 1) ph_post(p, lds, l);
        else if constexpr (q == 2) dn_chunk_local(p, lds, l);
        else if constexpr (q == 3) ph_mix(p, lds, l);
        else if constexpr (q == 4) dn_output(p, lds, l);
        else if constexpr (q == 5) ph_outproj(p, lds, l);
        else if constexpr (q == 6) ph_router(p, lds, l);
        else if constexpr (q == 7) ph_moe_gemm<1>(p, lds, l);
        else if constexpr (q == 8) ph_moe_gemm<2>(p, lds, l);
        else ph_combine(p, l);
    }
}

template <int PH> __global__ void __launch_bounds__(NTHREADS, 2) k_phase(Params p) {
    extern __shared__ __attribute__((aligned(16))) char smem[];
    run_phase<PH>(p, smem);
}

#ifndef PROBE_MASK
#define PROBE_MASK 0u
#endif
DEVI void grid_barrier(const Params& p, char* smem) {
    XcdBarrier b; b.bar = wsp<unsigned>(p, WS_CTL) + CW_BAR; b.x = xb_xcc_id(); b.st = (volatile LAS unsigned*)(LAS char*)(smem + LDS_BYTES - 16);
    xcd_barrier(b);
}
typedef const __attribute__((address_space(4))) Params CParams;
DEVI const Params& kargs() { CParams* k = (CParams*)__builtin_amdgcn_kernarg_segment_ptr(); asm volatile("" : "+s"(k)); return *(const Params*)k; }
template <int PH> DEVI void mega_seq(char* smem) {
    if constexpr (((PROBE_MASK) >> PH) & 1u) { run_phase<PH>(kargs(), smem); grid_barrier(kargs(), smem); }
    run_phase<PH>(kargs(), smem);
    if constexpr (PH + 1 < N_PHASES) { grid_barrier(kargs(), smem); mega_seq<PH + 1>(smem); }
}
__global__ void __launch_bounds__(NTHREADS, 2) k_mega(Params p) {
    extern __shared__ __attribute__((aligned(16))) char smem[];
    volatile LAS unsigned* st = (volatile LAS unsigned*)(LAS char*)(smem + LDS_BYTES - 16);
    if (threadIdx.x == 0) { st[0] = 0u; st[1] = 0u; st[2] = 0u; st[3] = 0u; }
    __syncthreads();
    (void)xcd_barrier_post(wsp<unsigned>(p, WS_CTL) + CW_BAR, st);
    mega_seq<0>(smem);
}

template <int PH> void launch_phase(const Params& p, int grid, hipStream_t s) {
    static bool attr = false;
    if (!attr) { (void)hipFuncSetAttribute((const void*)k_phase<PH>, hipFuncAttributeMaxDynamicSharedMemorySize, LDS_BYTES); attr = true; }
    hipLaunchKernelGGL(k_phase<PH>, dim3(grid), dim3(NTHREADS), LDS_BYTES, s, p);
}
template <int PH> void launch_all(const Params& p, int grid, hipStream_t s) { launch_phase<PH>(p, grid, s); if constexpr (PH + 1 < N_PHASES) launch_all<PH + 1>(p, grid, s); }
}

extern "C" void kernel_launch(void* const* d_in, const int* in_sizes, int n_in, void* d_out, int out_size, void* d_ws, size_t ws_size, hipStream_t stream) {
    (void)in_sizes; (void)out_size;
    static int grid = 0;
    if (grid == 0) {
        if (n_in != N_IN || ws_size < WS_TOTAL) { fprintf(stderr, "kernel_launch: unexpected inputs/workspace (n_in %d, ws %zu < %zu)\n", n_in, ws_size, (size_t)WS_TOTAL); grid = -1; return; }
        int dev = 0, cus = 0, per_cu = 0;
        (void)hipGetDevice(&dev); (void)hipDeviceGetAttribute(&cus, hipDeviceAttributeMultiprocessorCount, dev);
        (void)hipFuncSetAttribute((const void*)k_mega, hipFuncAttributeMaxDynamicSharedMemorySize, LDS_BYTES);
        if (hipOccupancyMaxActiveBlocksPerMultiprocessor(&per_cu, (const void*)k_mega, NTHREADS, LDS_BYTES) != hipSuccess || per_cu < 1) { fprintf(stderr, "kernel_launch: occupancy query says %d\n", per_cu); per_cu = 1; }
        (void)hipGetLastError();
        grid = cus > 0 ? cus : 256;
    }
    if (grid < 0) return;
    Params p{};
    for (int i = 0; i < N_IN; ++i) p.in[i] = (const float*)d_in[i];
    p.out = (float*)d_out; p.ws = (unsigned char*)d_ws; p.ph_lo = 0; p.ph_hi = N_PHASES;
    (void)hipMemsetAsync(d_ws, 0, CTL_BYTES, stream);
#if N_LAUNCH_MODE == 0
    launch_all<0>(p, grid, stream);
#else
    hipLaunchKernelGGL(k_mega, dim3(grid), dim3(NTHREADS), LDS_BYTES, stream, p);
#endif
}
```

```cpp
#include <hip/hip_runtime.h>
#include <cstdint>
#include <cstdio>
#include <type_traits>

#ifndef N_LAUNCH_MODE
#define N_LAUNCH_MODE 1
#endif

namespace {
typedef unsigned short bf16_t;
typedef short bf16x8 __attribute__((ext_vector_type(8)));
typedef float f32x4 __attribute__((ext_vector_type(4)));
typedef float f32x16 __attribute__((ext_vector_type(16)));
typedef unsigned u32x2 __attribute__((ext_vector_type(2)));
typedef unsigned u32x4 __attribute__((ext_vector_type(4)));
typedef int v4i_t __attribute__((ext_vector_type(4)));
typedef int v8i_t __attribute__((ext_vector_type(8)));

constexpr int D = 1024, NB = 8, SEQ = 4096, CTX = 256, GW = 64;
constexpr int NLAT = NB * SEQ, NCTX = NB * CTX, MROWS = NLAT + NCTX;
constexpr int KV = SEQ + CTX;
constexpr int INW = 2736, INWP = 2816;
constexpr int O_NAQ = 0, O_NAK = 256, O_NAV = 512, O_GQ = 768, O_GK = 1024, O_GV = 1152, O_DQ = 1280, O_DK = 1536, O_DV = 1792,
              O_DG = 2048, O_DB = 2304, O_DA = 2312, O_CQ = 2320, O_CKV = 2576, O_KPE = 2704;
constexpr int NEXP = 32, DEXP = 1024, TOPK = 4;
constexpr int NCH = KV / 64;
constexpr float EPS = 1e-6f, LOG2E = 1.4426950408889634f;
constexpr int NTHREADS = 512;

enum { I_X, I_C, I_CTX, I_CCTX, I_ADAW, I_ADAB, I_N1G, I_N2G, I_WIN, I_WOUT, I_NAQG, I_NAKG, I_NABIAS, I_GQG, I_GKG, I_DCONV, I_DALOG, I_DDT, I_DOUTG,
       I_MCQG, I_MCKVG, I_MWUQ, I_MWUKV, I_MQNG, I_MKNG, I_RW, I_RB, I_W1, I_B1, I_W2, I_B2, N_IN };

constexpr size_t al(size_t x) { return (x + 4095) & ~(size_t)4095; }
constexpr size_t WS_CTL = 0, CTL_BYTES = 1u << 16;
constexpr size_t WS_MODS = WS_CTL + CTL_BYTES;
constexpr size_t WS_TRG = al(WS_MODS + 2 * 9 * 6144 * 4);
constexpr size_t WS_TRM = al(WS_TRG + 4096 * 32 * 2 * 4);
constexpr size_t WS_WIN = al(WS_TRM + 4096 * 16 * 2 * 4);
constexpr size_t WS_WOUT = al(WS_WIN + (size_t)2 * INWP * D * 2);
constexpr size_t WS_WUQ = al(WS_WOUT + (size_t)2 * D * D * 2);
constexpr size_t WS_WUKV = al(WS_WUQ + 2 * 1024 * 384 * 2);
constexpr size_t WS_W1 = al(WS_WUKV + 2 * 512 * 128 * 2);
constexpr size_t WS_W2 = al(WS_W1 + (size_t)2 * NEXP * 2048 * D * 2);
constexpr size_t WS_XCUR = al(WS_W2 + (size_t)2 * NEXP * D * D * 2);
constexpr size_t WS_HB = al(WS_XCUR + (size_t)MROWS * D * 4);
constexpr size_t WS_LIST = al(WS_HB + (size_t)MROWS * D * 2);
constexpr size_t WS_GATE = al(WS_LIST + (size_t)NEXP * MROWS * 4);
constexpr size_t WS_SEL = al(WS_GATE + (size_t)MROWS * 4 * 4);
constexpr size_t WS_OVL = al(WS_SEL + (size_t)MROWS * 4 * 4);
constexpr size_t WS_P = WS_OVL;
constexpr size_t WS_G16 = al(WS_P + (size_t)MROWS * INWP * 2);
constexpr size_t HB64 = (size_t)NB * KV * 64 * 2;
constexpr size_t WS_QNA = al(WS_G16 + (size_t)MROWS * 16 * 4);
constexpr size_t WS_KNA = al(WS_QNA + 4 * HB64);
constexpr size_t WS_VTNA = al(WS_KNA + 4 * HB64);
constexpr size_t WS_QG = al(WS_VTNA + 4 * HB64);
constexpr size_t WS_KG = al(WS_QG + 4 * HB64);
constexpr size_t WS_VTG = al(WS_KG + 2 * HB64);
constexpr size_t WS_UQ = al(WS_VTG + 2 * HB64);
constexpr size_t WS_UKV = al(WS_UQ + (size_t)MROWS * 384 * 2);
constexpr size_t WS_QM = al(WS_UKV + (size_t)MROWS * 512 * 2);
constexpr size_t WS_KM = al(WS_QM + (size_t)NB * 4 * KV * 96 * 2);
constexpr size_t WS_VTM = al(WS_KM + (size_t)NB * 4 * KV * 96 * 2);
constexpr size_t WS_QD = al(WS_VTM + 4 * HB64);
constexpr size_t WS_KD = al(WS_QD + 4 * HB64);
constexpr size_t WS_VD = al(WS_KD + 4 * HB64);
constexpr size_t WS_KTD = al(WS_VD + 4 * HB64);
constexpr size_t WS_VTD = al(WS_KTD + 4 * HB64);
constexpr size_t WS_DG = al(WS_VTD + 4 * HB64);
constexpr size_t WS_DBETA = al(WS_DG + (size_t)NB * 4 * 2 * KV * 4);
constexpr size_t DNMAT = (size_t)NB * 4 * 2 * NCH * 4096 * 4;
constexpr size_t WS_DU = al(WS_DBETA + (size_t)NB * 4 * 2 * KV * 4);
constexpr size_t WS_DW = al(WS_DU + DNMAT);
constexpr size_t WS_DM = al(WS_DW + DNMAT);
constexpr size_t WS_DN = al(WS_DM + DNMAT);
constexpr size_t WS_DS = al(WS_DN + DNMAT);
constexpr size_t WS_Y = al(WS_DS + DNMAT);
constexpr size_t WS_END1 = al(WS_Y + (size_t)MROWS * D * 2);
constexpr int HROWS_MAX = MROWS * TOPK + NEXP * 256;
constexpr size_t WS_H = WS_OVL;
constexpr size_t WS_YEXP = al(WS_H + (size_t)HROWS_MAX * DEXP * 2);
constexpr size_t WS_END2 = al(WS_YEXP + (size_t)MROWS * TOPK * D * 2);
constexpr size_t WS_TOTAL = WS_END1 > WS_END2 ? WS_END1 : WS_END2;
static_assert(WS_TOTAL < (size_t)2100 * 1000 * 1000, "workspace map exceeds the guaranteed 4 x largest tensor");

constexpr int CW_BAR = 0;
constexpr int CW_CNT = 4096;
constexpr int CW_ERR = 8192;
constexpr int CW_Q = 12288;
constexpr int CW_MLAQ = 14336;
static_assert((CW_MLAQ + 2 * 64) * 4 <= (int)CTL_BYTES && (CW_Q + 16 * 64) <= CW_MLAQ && CW_CNT + 2 * 64 <= CW_ERR && 3456 <= CW_CNT, "control words inside the per-call memset");

constexpr int LDS_BYTES = 150528;

struct Params { const float* in[N_IN]; float* out; unsigned char* ws; int ph_lo, ph_hi; };

#define DEVI __device__ __forceinline__
DEVI int tid_fresh() { int t = threadIdx.x; asm volatile("" : "+v"(t)); return t; }
DEVI float bf2f(bf16_t x) { return __builtin_bit_cast(float, (unsigned)x << 16); }
DEVI bf16_t f2bf(float f) { unsigned u = __builtin_bit_cast(unsigned, f); return (bf16_t)((u + 0x7fffu + ((u >> 16) & 1u)) >> 16); }
typedef float f32x2_t __attribute__((ext_vector_type(2)));
typedef __bf16 bf16x2_t __attribute__((ext_vector_type(2)));
DEVI unsigned pk2(float lo, float hi) { const f32x2_t v = {lo, hi}; const bf16x2_t b = __builtin_convertvector(v, bf16x2_t); return __builtin_bit_cast(unsigned, b); }
DEVI void unpk8(const u32x4& w, float* v) {
    v[0] = __builtin_bit_cast(float, w.x << 16); v[1] = __builtin_bit_cast(float, w.x & 0xffff0000u); v[2] = __builtin_bit_cast(float, w.y << 16); v[3] = __builtin_bit_cast(float, w.y & 0xffff0000u);
    v[4] = __builtin_bit_cast(float, w.z << 16); v[5] = __builtin_bit_cast(float, w.z & 0xffff0000u); v[6] = __builtin_bit_cast(float, w.w << 16); v[7] = __builtin_bit_cast(float, w.w & 0xffff0000u); }
DEVI float clamp8(float x) { return fminf(fmaxf(x, -448.f), 448.f); }
DEVI unsigned pk4_fp8(float a, float b, float c, float d) { int w = __builtin_amdgcn_cvt_pk_fp8_f32(clamp8(a), clamp8(b), 0, false); w = __builtin_amdgcn_cvt_pk_fp8_f32(clamp8(c), clamp8(d), w, true); return (unsigned)w; }
constexpr float S8_Y = 16.f;
constexpr float S8_ACT = 8.f, S8_W = 32.f, S8_INV = 1.f / (S8_ACT * S8_W);
DEVI float wave_sum(float v) {
    int x;
    x = __builtin_bit_cast(int, v); v += __builtin_bit_cast(float, __builtin_amdgcn_update_dpp(0, x, 0xB1, 0xF, 0xF, true));
    x = __builtin_bit_cast(int, v); v += __builtin_bit_cast(float, __builtin_amdgcn_update_dpp(0, x, 0x4E, 0xF, 0xF, true));
    x = __builtin_bit_cast(int, v); v += __builtin_bit_cast(float, __builtin_amdgcn_update_dpp(0, x, 0x141, 0xF, 0xF, true));
    x = __builtin_bit_cast(int, v); v += __builtin_bit_cast(float, __builtin_amdgcn_update_dpp(0, x, 0x140, 0xF, 0xF, true));
    x = __builtin_bit_cast(int, v);
    return (__builtin_bit_cast(float, __builtin_amdgcn_readlane(x, 0)) + __builtin_bit_cast(float, __builtin_amdgcn_readlane(x, 16))) + (__builtin_bit_cast(float, __builtin_amdgcn_readlane(x, 32)) + __builtin_bit_cast(float, __builtin_amdgcn_readlane(x, 48)));
}
DEVI float sigmoidf(float y) { return __builtin_amdgcn_rcpf(1.f + __builtin_amdgcn_exp2f(-LOG2E * y)); }
DEVI float siluf(float y) { return y * sigmoidf(y); }
DEVI void row2bp(int row, int& b, int& pos) { if (row < NLAT) { b = row >> 12; pos = row & 4095; } else { const int r = row - NLAT; b = r >> 8; pos = SEQ + (r & 255); } }
DEVI int bp2row(int b, int pos) { return pos < SEQ ? b * SEQ + pos : NLAT + b * CTX + (pos - SEQ); }

template <class T> DEVI T* wsp(const Params& p, size_t off) { return (T*)(p.ws + off); }


#define XB_TMO      128
#define XB_XCNT(j)  (256  + 64 * (j))
#define XB_XSUB(j)  (1280 + 64 * (j))
#define XB_XGEN(j)  (2304 + 64 * (j))
#define XB_TOP      3328
#define XB_TOPGEN   3392
#define XCD_BAR_WORDS 3456
#define XB_SPIN_CAP (1u << 18)
#define LAS __attribute__((address_space(3)))
__device__ __forceinline__ unsigned xb_ld(unsigned* p)              { return __hip_atomic_load(p, __ATOMIC_RELAXED, __HIP_MEMORY_SCOPE_AGENT); }
__device__ __forceinline__ unsigned xb_add(unsigned* p, unsigned v) { return __hip_atomic_fetch_add(p, v, __ATOMIC_RELAXED, __HIP_MEMORY_SCOPE_AGENT); }
__device__ __forceinline__ unsigned xb_xcc_id() { return (unsigned)__builtin_amdgcn_s_getreg((3 << 11) | 20) & 0xFu; }
#define XB_SPIN(cond, bar) do { unsigned _sp = 0; while (cond) { __builtin_amdgcn_s_sleep(1); \
    if ((++_sp & 255u) == 0u) { if (xb_ld(&(bar)[XB_TMO])) break; if (_sp > XB_SPIN_CAP) { atomicAdd(&(bar)[XB_TMO], 1u); break; } } } } while (0)
struct XcdBarrier { unsigned* bar; unsigned x; volatile LAS unsigned* st; };
__device__ __forceinline__ XcdBarrier xcd_barrier_post(unsigned* bar, volatile LAS unsigned* st) {
    XcdBarrier b; b.bar = bar; b.x = xb_xcc_id(); b.st = st;
    if (threadIdx.x == 0) (void)xb_add(&bar[XB_XCNT(b.x)], 1u);
    return b;
}
__device__ __forceinline__ void xcd_barrier_complete(unsigned* bar, unsigned x, unsigned& nloc, unsigned& nx) {
    const unsigned G = gridDim.x * gridDim.y * gridDim.z;
    unsigned sum, cnt, mine, sp = 0u;
    for (;;) {
        sum = 0u; cnt = 0u; mine = 0u;
#pragma unroll
        for (unsigned j = 0; j < 16; ++j) { const unsigned c = xb_ld(&bar[XB_XCNT(j)]); sum += c; cnt += (c > 0u) ? 1u : 0u; mine = (j == x) ? c : mine; }
        if (sum == G) break;
        __builtin_amdgcn_s_sleep(1);
        if ((++sp & 255u) == 0u) { if (xb_ld(&bar[XB_TMO])) break; if (sp > XB_SPIN_CAP) { atomicAdd(&bar[XB_TMO], 1u); break; } }
    }
    nloc = mine > 0u ? mine : 1u; nx = cnt > 0u ? cnt : 1u;
}
__device__ __forceinline__ void xcd_barrier(const XcdBarrier& b) {
    asm volatile("s_waitcnt vmcnt(0)" ::: "memory");
    __syncthreads();
    if (threadIdx.x == 0) {
        unsigned* bar = b.bar;
        __builtin_amdgcn_s_waitcnt(0);
        unsigned nloc = b.st[0], nx = b.st[1];
        if (nloc == 0u) { xcd_barrier_complete(bar, b.x, nloc, nx); b.st[0] = nloc; b.st[1] = nx; }
        const unsigned old = xb_add(&bar[XB_XSUB(b.x)], 1u);
        const unsigned gen = old / nloc;
        if (old + 1u == (gen + 1u) * nloc) {
            __builtin_amdgcn_fence(__ATOMIC_RELEASE, "agent");
            asm volatile("s_waitcnt vmcnt(0)" ::: "memory");
            const unsigned og = xb_add(&bar[XB_TOP], 1u);
            const unsigned tg = og / nx;
            if (og + 1u == (tg + 1u) * nx) xb_add(&bar[XB_TOPGEN], 1u);
            else XB_SPIN(xb_ld(&bar[XB_TOPGEN]) == tg, bar);
            __builtin_amdgcn_fence(__ATOMIC_ACQUIRE, "agent");
            xb_add(&bar[XB_XGEN(b.x)], 1u);
            asm volatile("s_waitcnt vmcnt(0)" ::: "memory");
        } else {
            XB_SPIN(xb_ld(&bar[XB_XGEN(b.x)]) == gen, bar);
            __builtin_amdgcn_fence(__ATOMIC_ACQUIRE, "agent");
            asm volatile("s_waitcnt vmcnt(0)" ::: "memory");
        }
    }
    __syncthreads();
}

template <int NS> DEVI void tr_tile(const float* src, int ld, int k0, int n0, int nvalid, const float* rs, bf16_t* dst, int K, int perm, float* tile, bool fp8 = false) {
    const int tid = tid_fresh();
    { const int kk = tid >> 3, c8 = (tid & 7) * 8; f32x4 va[NS], vb[NS];
#pragma unroll
      for (int q = 0; q < NS; ++q) { const int n = n0 + q * 64 + c8;
          if (n < nvalid) { const float* sp = src + (size_t)(k0 + kk) * ld + n; va[q] = *(const f32x4*)sp; vb[q] = *(const f32x4*)(sp + 4); }
          else { va[q] = (f32x4){0.f, 0.f, 0.f, 0.f}; vb[q] = va[q]; } }
      const float sc = rs ? rs[k0 + kk] : 1.f;
#pragma unroll
      for (int q = 0; q < NS; ++q) { float* t = tile + q * 64 * 65 + kk * 65 + c8;
#pragma unroll
          for (int j = 0; j < 4; ++j) { t[j] = va[q][j] * sc; t[4 + j] = vb[q][j] * sc; } } }
    __syncthreads();
    { const int nn = tid >> 3, k8 = (tid & 7) * 8;
#pragma unroll
      for (int q = 0; q < NS; ++q) { const float* t = tile + q * 64 * 65; float v[8];
#pragma unroll
          for (int j = 0; j < 8; ++j) v[j] = t[(k8 + j) * 65 + nn];
          const int n = n0 + q * 64 + nn; int drow = n;
          if (perm) { const int j = n & 1023, hi = n >> 10; drow = (j >> 7) * 256 + hi * 128 + (j & 127); }
          if (!fp8) { u32x4 w; w.x = pk2(v[0], v[1]); w.y = pk2(v[2], v[3]); w.z = pk2(v[4], v[5]); w.w = pk2(v[6], v[7]); *(u32x4*)(dst + (size_t)drow * K + k0 + k8) = w; }
          else { u32x2 w8; w8.x = pk4_fp8(v[0] * S8_W, v[1] * S8_W, v[2] * S8_W, v[3] * S8_W); w8.y = pk4_fp8(v[4] * S8_W, v[5] * S8_W, v[6] * S8_W, v[7] * S8_W);
              *(u32x2*)((unsigned char*)dst + (size_t)drow * K + k0 + k8) = w8; } } }
    __syncthreads();
}

DEVI void ph_prologue(const Params& p, char* lds) {
    const int tid = tid_fresh(), lane = tid & 63, wid = tid >> 6;
    if (blockIdx.x < 192) {
        float* sv = (float*)lds;
        float* red = (float*)(lds + 36864);
        for (int i = tid; i < 9 * 1024; i += NTHREADS) { const int r = i >> 10, k = i & 1023; const float c = r < 8 ? p.in[I_C][r * 1024 + k] : p.in[I_CCTX][k]; sv[i] = siluf(c); }
        __syncthreads();
        for (int it = blockIdx.x; it < 192; it += gridDim.x) {
            const int l = it / 96, cg = it % 96;
            const float* W = p.in[I_ADAW] + (size_t)l * D * 6144 + cg * 64 + lane;
            float acc[9];
#pragma unroll
            for (int r = 0; r < 9; ++r) acc[r] = 0.f;
            for (int k = wid * 128; k < wid * 128 + 128; ++k) { const float w = W[(size_t)k * 6144];
#pragma unroll
                for (int r = 0; r < 9; ++r) acc[r] += sv[r * 1024 + k] * w; }
#pragma unroll
            for (int r = 0; r < 9; ++r) red[(wid * 9 + r) * 64 + lane] = acc[r];
            __syncthreads();
            for (int i = tid; i < 576; i += NTHREADS) { const int r = i >> 6, c = i & 63; float s = 0.f;
#pragma unroll
                for (int w = 0; w < 8; ++w) s += red[(w * 9 + r) * 64 + c];
                wsp<float>(p, WS_MODS)[(size_t)(l * 9 + r) * 6144 + cg * 64 + c] = s + p.in[I_ADAB][l * 6144 + cg * 64 + c]; }
            __syncthreads();
        }
    }
    for (int i = blockIdx.x * NTHREADS + tid; i < 4096 * 48; i += gridDim.x * NTHREADS) {
        const int t = i / 48, q = i % 48; const float row = (float)(t / GW), col = (float)(t % GW);
        if (q < 32) { const int f = q & 15; const float fr = powf(10000.f, -(float)f / 16.f); const float a = (q < 16 ? row : col) * fr; float s, c; sincosf(a, &s, &c);
            float* o = wsp<float>(p, WS_TRG) + ((size_t)t * 32 + q) * 2; o[0] = c; o[1] = s; }
        else { const int qq = q - 32, f = qq & 7; const float fr = powf(10000.f, -(float)f / 8.f); const float a = (qq < 8 ? row : col) * fr; float s, c; sincosf(a, &s, &c);
            float* o = wsp<float>(p, WS_TRM) + ((size_t)t * 16 + qq) * 2; o[0] = c; o[1] = s; }
    }
    float* tile = (float*)lds;
    constexpr int T_W1 = 64 * 128, T_W2 = 64 * 64, T_WIN = 2 * 16 * 11, T_WOUT = 2 * 64, T_WUQ = 2 * 4 * 2, T_WUKV = 2 * 2 * 2, T_WUZ = 2 * 18;
    constexpr int T_ALL = T_W1 + T_W2 + T_WIN + T_WOUT + T_WUQ + T_WUKV + T_WUZ;
    for (int it = blockIdx.x; it < T_ALL; it += gridDim.x) {
        int i = it;
        if (i < T_W1) { const int le = i >> 7, t = i & 127, kt = t >> 3, nt = t & 7;
            tr_tile<4>(p.in[I_W1] + (size_t)le * D * 2048, 2048, kt * 64, nt * 256, 2048, nullptr, (bf16_t*)(wsp<unsigned char>(p, WS_W1) + (size_t)le * 2048 * D), D, 1, tile, true); continue; }
        i -= T_W1;
        if (i < T_W2) { const int le = i >> 6, t = i & 63, kt = t >> 2, nt = t & 3;
            tr_tile<4>(p.in[I_W2] + (size_t)le * DEXP * D, D, kt * 64, nt * 256, D, nullptr, (bf16_t*)(wsp<unsigned char>(p, WS_W2) + (size_t)le * D * DEXP), DEXP, 0, tile, true); continue; }
        i -= T_W2;
        if (i < T_WIN) { const int l = i / 176, t = i % 176, kt = t / 11, nt = t % 11;
            tr_tile<4>(p.in[I_WIN] + (size_t)l * D * INW, INW, kt * 64, nt * 256, INW, nullptr, (bf16_t*)(wsp<unsigned char>(p, WS_WIN) + (size_t)l * INWP * D), D, 0, tile, true); continue; }
        i -= T_WIN;
        if (i < T_WOUT) { const int l = i >> 6, t = i & 63, kt = t >> 2, nt = t & 3;
            tr_tile<4>(p.in[I_WOUT] + (size_t)l * D * D, D, kt * 64, nt * 256, D, nullptr, (bf16_t*)(wsp<unsigned char>(p, WS_WOUT) + (size_t)l * D * D), D, 0, tile, true); continue; }
        i -= T_WOUT;
        if (i < T_WUQ) { const int l = i / 8, t = i % 8, kt = t / 2, nt = t % 2;
            tr_tile<4>(p.in[I_MWUQ] + (size_t)l * 256 * 384, 384, kt * 64, nt * 256, 384, p.in[I_MCQG] + l * 256, wsp<bf16_t>(p, WS_WUQ) + (size_t)l * 1024 * 384, 384, 0, tile); continue; }
        i -= T_WUQ;
        if (i < T_WUKV) { const int l = i / 4, t = i % 4, kt = t / 2, nt = t % 2;
            tr_tile<4>(p.in[I_MWUKV] + (size_t)l * 128 * 512, 512, kt * 64, nt * 256, 512, p.in[I_MCKVG] + l * 128, wsp<bf16_t>(p, WS_WUQ) + (size_t)l * 1024 * 384 + 384 * 384 + 256, 384, 0, tile); continue; }
        i -= T_WUKV;
        { const int l = i / 18, t = i % 18; bf16_t* base = wsp<bf16_t>(p, WS_WUQ) + (size_t)l * 1024 * 384;
            if (t < 6) tr_tile<2>(p.in[I_MWUQ], 384, 256 + (t / 3) * 64, (t % 3) * 128, 0, nullptr, base, 384, 0, tile);
            else { const int u = t - 6; tr_tile<2>(p.in[I_MWUQ], 384, (u / 3) * 64, (u % 3) * 128, 0, nullptr, base + 512 * 384, 384, 0, tile); } }
    }
}

DEVI void norm_mod_row(const float* x, const float* g, const float* shift, const float* scale, bf16_t* out, int lane, float (*keep)[4] = nullptr, unsigned char* out8 = nullptr) {
    f32x4 v[4]; float ss = 0.f;
#pragma unroll
    for (int i = 0; i < 4; ++i) { v[i] = *(const f32x4*)(x + i * 256 + lane * 4); ss += v[i][0] * v[i][0] + v[i][1] * v[i][1] + v[i][2] * v[i][2] + v[i][3] * v[i][3]; }
    ss = wave_sum(ss); const float r = rsqrtf(ss * (1.f / 1024.f) + EPS);
#pragma unroll
    for (int i = 0; i < 4; ++i) { const int c = i * 256 + lane * 4; const f32x4 gg = *(const f32x4*)(g + c), sh = *(const f32x4*)(shift + c), sc = *(const f32x4*)(scale + c);
        f32x4 y;
#pragma unroll
        for (int j = 0; j < 4; ++j) { y[j] = (v[i][j] * r * gg[j]) * (1.f + sc[j]) + sh[j]; if (keep) keep[i][j] = y[j]; }
        if (out8) *(unsigned*)(out8 + c) = pk4_fp8(y[0] * S8_ACT, y[1] * S8_ACT, y[2] * S8_ACT, y[3] * S8_ACT);
        else { u32x2 w; w.x = pk2(y[0], y[1]); w.y = pk2(y[2], y[3]); *(u32x2*)(out + c) = w; } }
}
DEVI const float* mod_vec(const Params& p, int l, int row, int which) {
    const int r = row < NLAT ? (row >> 12) : 8; return wsp<float>(p, WS_MODS) + (size_t)(l * 9 + r) * 6144 + which * 1024; }

DEVI void ph_norm1_l0(const Params& p) {
    const int tid = tid_fresh(), lane = tid & 63, gw = blockIdx.x * 8 + (tid >> 6), nw = gridDim.x * 8;
    for (int row = gw; row < MROWS; row += nw) {
        const float* x = row < NLAT ? p.in[I_X] + (size_t)row * D : p.in[I_CTX] + (size_t)(row - NLAT) * D;
        norm_mod_row(x, p.in[I_N1G], mod_vec(p, 0, row, 0), mod_vec(p, 0, row, 1), nullptr, lane, nullptr, wsp<unsigned char>(p, WS_HB) + (size_t)row * D);
    }
}

struct GUnit { const bf16_t* A; size_t lda; const int* rows; int nvalid, rshift; const bf16_t* B; size_t ldb; int m0, n0, e, tr; };
constexpr int G_LDS = 2 * 128 * 72 * 2;
template <class Epi> DEVI void gemm_unit(char* lds, const GUnit& u, int K, const Epi& E) {
    const int tid = tid_fresh(), lane = tid & 63, wid = tid >> 6, wm = wid >> 1, wn = wid & 1;
    bf16_t* As = (bf16_t*)lds; bf16_t* Bs = As + 128 * 72;
    const int r0 = tid >> 3, ch = tid & 7;
    const bf16_t* ap[2]; const bf16_t* bp[2];
#pragma unroll
    for (int i = 0; i < 2; ++i) { const int r = r0 + 64 * i;
        size_t arow; if (u.rows) arow = (r < u.nvalid) ? (size_t)(u.rows[r] >> u.rshift) : 0; else arow = (size_t)(u.m0 + r);
        ap[i] = u.A + arow * u.lda + ch * 8; bp[i] = u.B + (size_t)(u.n0 + r) * u.ldb + ch * 8; }
    f32x4 acc[2][4];
#pragma unroll
    for (int a = 0; a < 2; ++a)
#pragma unroll
        for (int b = 0; b < 4; ++b) acc[a][b] = (f32x4){0.f, 0.f, 0.f, 0.f};
    u32x4 ra[2], rb[2];
#pragma unroll
    for (int i = 0; i < 2; ++i) { ra[i] = *(const u32x4*)ap[i]; rb[i] = *(const u32x4*)bp[i]; }
    const int nk = K / 64;
    for (int kt = 0; kt < nk; ++kt) {
        __syncthreads();
#pragma unroll
        for (int i = 0; i < 2; ++i) { *(u32x4*)(As + (r0 + 64 * i) * 72 + ch * 8) = ra[i]; *(u32x4*)(Bs + (r0 + 64 * i) * 72 + ch * 8) = rb[i]; }
        __syncthreads();
        if (kt + 1 < nk) {
#pragma unroll
            for (int i = 0; i < 2; ++i) { ra[i] = *(const u32x4*)(ap[i] + (kt + 1) * 64); rb[i] = *(const u32x4*)(bp[i] + (kt + 1) * 64); } }
#pragma unroll
        for (int ks = 0; ks < 2; ++ks) {
            bf16x8 af[2], bfr[4];
#pragma unroll
            for (int mt = 0; mt < 2; ++mt) af[mt] = *(const bf16x8*)(As + (wm * 32 + mt * 16 + (lane & 15)) * 72 + ks * 32 + 8 * (lane >> 4));
#pragma unroll
            for (int nt = 0; nt < 4; ++nt) bfr[nt] = *(const bf16x8*)(Bs + (wn * 64 + nt * 16 + (lane & 15)) * 72 + ks * 32 + 8 * (lane >> 4));
#pragma unroll
            for (int mt = 0; mt < 2; ++mt)
#pragma unroll
                for (int nt = 0; nt < 4; ++nt) acc[mt][nt] = __builtin_amdgcn_mfma_f32_16x16x32_bf16(bfr[nt], af[mt], acc[mt][nt], 0, 0, 0);
        }
    }
    E(acc, u, wm, wn, lane);
}

struct EpiP { bf16_t* P; float* G16;
    DEVI void operator()(const f32x4 (&acc)[2][4], const GUnit& u, int wm, int wn, int lane) const {
#pragma unroll
        for (int mt = 0; mt < 2; ++mt)
#pragma unroll
            for (int nt = 0; nt < 4; ++nt) { const int row = u.m0 + wm * 32 + mt * 16 + (lane & 15), col = u.n0 + wn * 64 + nt * 16 + 4 * (lane >> 4); const f32x4 v = acc[mt][nt];
                u32x2 w; w.x = pk2(v[0], v[1]); w.y = pk2(v[2], v[3]); *(u32x2*)(P + (size_t)row * INWP + col) = w;
                if (col >= O_DB && col < O_DB + 16) *(f32x4*)(G16 + (size_t)row * 16 + (col - O_DB)) = v; }
    } };
struct EpiBf { bf16_t* O; int ldo;
    DEVI void operator()(const f32x4 (&acc)[2][4], const GUnit& u, int wm, int wn, int lane) const {
#pragma unroll
        for (int mt = 0; mt < 2; ++mt)
#pragma unroll
            for (int nt = 0; nt < 4; ++nt) { const int row = u.m0 + wm * 32 + mt * 16 + (lane & 15), col = u.n0 + wn * 64 + nt * 16 + 4 * (lane >> 4); const f32x4 v = acc[mt][nt];
                u32x2 w; w.x = pk2(v[0], v[1]); w.y = pk2(v[2], v[3]); *(u32x2*)(O + (size_t)row * ldo + col) = w; }
    } };
struct EpiOut { const Params* p; int l;
    DEVI void operator()(const f32x4 (&acc)[2][4], const GUnit& u, int wm, int wn, int lane) const {
#pragma unroll
        for (int mt = 0; mt < 2; ++mt) { const int row = u.m0 + wm * 32 + mt * 16 + (lane & 15);
            const float* base = l == 0 ? (row < NLAT ? p->in[I_X] + (size_t)row * D : p->in[I_CTX] + (size_t)(row - NLAT) * D) : wsp<float>(*p, WS_XCUR) + (size_t)row * D;
            const float* g = mod_vec(*p, l, row, 2); float* o = wsp<float>(*p, WS_XCUR) + (size_t)row * D;
#pragma unroll
            for (int nt = 0; nt < 4; ++nt) { const int col = u.n0 + wn * 64 + nt * 16 + 4 * (lane >> 4); const f32x4 bs = *(const f32x4*)(base + col), gg = *(const f32x4*)(g + col);
                *(f32x4*)(o + col) = bs + gg * acc[mt][nt]; } }
    } };
struct EpiH { bf16_t* H; const float* b1;
    DEVI void operator()(const f32x4 (&acc)[2][4], const GUnit& u, int wm, int wn, int lane) const {
        const float* bb = b1 + (size_t)u.e * 2048;
#pragma unroll
        for (int mt = 0; mt < 2; ++mt) { const size_t hrow = (size_t)u.tr * 128 + wm * 32 + mt * 16 + (lane & 15);
#pragma unroll
            for (int g = 0; g < 2; ++g) { const int acol = (u.n0 >> 1) + wn * 32 + g * 16 + 4 * (lane >> 4);
                const f32x4 bg = *(const f32x4*)(bb + acol), bl = *(const f32x4*)(bb + 1024 + acol); f32x4 o;
#pragma unroll
                for (int j = 0; j < 4; ++j) { const float glu = fminf(acc[mt][2 * g][j] + bg[j], 7.f); const float lin = fminf(fmaxf(acc[mt][2 * g + 1][j] + bl[j], -7.f), 7.f);
                    o[j] = glu * sigmoidf(1.702f * glu) * (lin + 1.f); }
                u32x2 w; w.x = pk2(o[0], o[1]); w.y = pk2(o[2], o[3]); *(u32x2*)(H + hrow * DEXP + acol) = w; } }
    } };
struct EpiY { bf16_t* Y; const float* b2; const int* rows;
    DEVI void operator()(const f32x4 (&acc)[2][4], const GUnit& u, int wm, int wn, int lane) const {
        const float* bb = b2 + (size_t)u.e * D;
#pragma unroll
        for (int mt = 0; mt < 2; ++mt) { const int r = wm * 32 + mt * 16 + (lane & 15); if (r >= u.nvalid) continue; const size_t yrow = (size_t)rows[r];
#pragma unroll
            for (int nt = 0; nt < 4; ++nt) { const int col = u.n0 + wn * 64 + nt * 16 + 4 * (lane >> 4); const f32x4 v = acc[mt][nt] + *(const f32x4*)(bb + col);
                u32x2 w; w.x = pk2(v[0], v[1]); w.y = pk2(v[2], v[3]); *(u32x2*)(Y + yrow * D + col) = w; } }
    } };

template <class Epi> DEVI void gemm_dense(char* lds, const bf16_t* A, size_t lda, const bf16_t* B, size_t ldb, int Mrows, int Ncols, int K, const Epi& E) {
    const int nt = Ncols / 128, total = (Mrows / 128) * nt;
    for (int i = blockIdx.x; i < total; i += gridDim.x) { GUnit u; u.A = A; u.lda = lda; u.rows = nullptr; u.nvalid = 128; u.rshift = 0; u.B = B; u.ldb = ldb; u.m0 = (i / nt) * 128; u.n0 = (i % nt) * 128; u.e = 0; u.tr = 0;
        gemm_unit(lds, u, K, E); }
}

namespace pg8 {
constexpr int BM = 256, BK = 64, HALF = 128, HTB = HALF * BK * 2, STAGE_BYTES = 8 * HTB;
DEVI int lds_byte(int r, int c) { const int st = (r >> 4) * 2 + (c >> 5), rr = r & 15, cc = c & 31, ob = rr * 64 + cc * 2; return st * 1024 + (ob ^ (((ob >> 9) & 1) << 5)); }
DEVI void stage_rc(int b, int& R, int& C) { const int st = b / 1024, sb = b % 1024, swz = sb ^ (((sb >> 9) & 1) << 5); R = (st >> 1) * 16 + swz / 64; C = (st & 1) * 32 + (swz % 64) / 2; }
DEVI int perm32(int rho) { const int n = rho >> 4, i = rho & 15; return 8 * (i >> 2) + 4 * n + (i & 3); }
struct Unit { int pm, pn, e, nvalid; const int* rows; };
template <class E, class = void> struct EpiLds { static constexpr bool has = false; };
template <class E> struct EpiLds<E, std::void_t<typename E::LdsBias>> { static constexpr bool has = true; };
template <bool FP8, bool ALIGN_EPI, class Epi, class Sched>
DEVI void gemm_phase(LAS unsigned char* lds, const int kbytes  , const Sched& S, const Epi& E) {
    const int tid = tid_fresh(), wid = __builtin_amdgcn_readfirstlane(tid >> 6), lane = tid & 63, wr = wid >> 2, wc = wid & 3, fr = lane & 15, fq = lane >> 4;
    const int nt = kbytes / (BK * 2);
    unsigned voffB[2];
#pragma unroll
    for (int i = 0; i < 2; ++i) { int R, C; stage_rc(tid * 16 + i * 8192, R, C); const int Rb = (R & ~31) + perm32(R & 31); voffB[i] = (unsigned)Rb * S.ldb_b + (unsigned)C * 2u; }
    const size_t kstep = (size_t)(BK * 2);
    const size_t hstepB = (size_t)HALF * S.ldb_b;
    const unsigned ldsw = (unsigned)wid * 1024u;
    const int aoff = lds_byte(wr * 64 + fr, fq * 8), boff = lds_byte(wc * 32 + fr, fq * 8);
#define PG8_SA(b, h) (((b) * 2 + (h)) * HTB)
#define PG8_SB(b, h) ((4 + (b) * 2 + (h)) * HTB)
#define PG8_STAGE(bufoff, gbase, voff) do { _Pragma("unroll") for (int _i = 0; _i < 2; ++_i) \
        __builtin_amdgcn_global_load_lds((const unsigned*)((const char*)(gbase) + (voff)[_i]), (LAS unsigned*)(lds + (bufoff) + ldsw + _i * 8192), 16, 0, 0); } while (0)
#define PG8_LDA(dst, b, h) do { _Pragma("unroll") for (int m = 0; m < 4; ++m) dst[m] = __builtin_shufflevector(*(const LAS v4i_t*)(lds + PG8_SA(b, h) + aoff + m * 2048), *(const LAS v4i_t*)(lds + PG8_SA(b, h) + aoff + m * 2048 + 1024), 0, 1, 2, 3, 4, 5, 6, 7); } while (0)
#define PG8_LDB(dst, b, h) do { _Pragma("unroll") for (int n = 0; n < 2; ++n) dst[n] = __builtin_shufflevector(*(const LAS v4i_t*)(lds + PG8_SB(b, h) + boff + n * 2048), *(const LAS v4i_t*)(lds + PG8_SB(b, h) + boff + n * 2048 + 1024), 0, 1, 2, 3, 4, 5, 6, 7); } while (0)
#define PG8_LO(x) __builtin_bit_cast(bf16x8, __builtin_shufflevector(x, x, 0, 1, 2, 3))
#define PG8_HI(x) __builtin_bit_cast(bf16x8, __builtin_shufflevector(x, x, 4, 5, 6, 7))
#define PG8_MMA(ai, bj, At, Bt) do { if constexpr (FP8) __builtin_amdgcn_sched_barrier(0); __builtin_amdgcn_s_setprio(1); _Pragma("unroll") for (int m = 0; m < 4; ++m) _Pragma("unroll") for (int n = 0; n < 2; ++n) { \
        if constexpr (FP8) asm volatile("v_mfma_scale_f32_16x16x128_f8f6f4 %0, %1, %2, %0, %3, %3 op_sel_hi:[0,0,0]" : "+v"(acc[ai][bj][m][n]) : "v"(Bt[n]), "v"(At[m]), "v"(one8)); \
        else { acc[ai][bj][m][n] = __builtin_amdgcn_mfma_f32_16x16x32_bf16(PG8_LO(Bt[n]), PG8_LO(At[m]), acc[ai][bj][m][n], 0, 0, 0); \
               acc[ai][bj][m][n] = __builtin_amdgcn_mfma_f32_16x16x32_bf16(PG8_HI(Bt[n]), PG8_HI(At[m]), acc[ai][bj][m][n], 0, 0, 0); } } __builtin_amdgcn_s_setprio(0); if constexpr (FP8) __builtin_amdgcn_sched_barrier(0); } while (0)
#define PG8_WAIT_V(n) asm volatile("s_waitcnt vmcnt(" #n ")" ::: "memory")
#define PG8_WAIT_L(n) asm volatile("s_waitcnt lgkmcnt(" #n ")" ::: "memory")
#define PG8_WAIT_VR(rl) do { static_assert(Epi::NST == 0 || Epi::NST == 8 || Epi::NST == 16, "NST"); if constexpr (Epi::NST == 16) { if (rl) PG8_WAIT_V(24); else PG8_WAIT_V(8); } else if constexpr (Epi::NST == 8) { if (rl) PG8_WAIT_V(16); else PG8_WAIT_V(8); } else PG8_WAIT_V(8); } while (0)
#define PG8_BAR __builtin_amdgcn_s_barrier()
#define PG8_SCHED __builtin_amdgcn_sched_barrier(0)
    Unit cur, nxt; int ui = 0; cur.e = 0;
    if (!S.next(0, cur)) return;
    unsigned vAc[2][2];
    LAS int* tab = (LAS int*)(lds + STAGE_BYTES + 1024);
    auto a_offsets = [&](const Unit& u, unsigned (&v)[2][2], bool from_tab) {
        int t2 = tid; asm volatile("" : "+v"(t2));
#pragma unroll
        for (int i = 0; i < 2; ++i) { int R, C; stage_rc(t2 * 16 + i * 8192, R, C);
#pragma unroll
            for (int h = 0; h < 2; ++h) { const int rr = h * HALF + R;
                unsigned arow; if constexpr (Sched::GATHER) { if (u.rows) { const int e = from_tab ? tab[rr] : u.rows[rr]; arow = rr < u.nvalid ? (unsigned)(e >> S.rshift) : 0u; } else arow = (unsigned)(u.pm * BM + rr); } else arow = (unsigned)(u.pm * BM + rr);
                v[h][i] = arow * S.lda_b + (unsigned)C * 2u; } } };
    a_offsets(cur, vAc, false);
    f32x4 acc[2][2][4][2];
#pragma unroll
    for (int a = 0; a < 2; ++a)
#pragma unroll
        for (int b = 0; b < 2; ++b)
#pragma unroll
            for (int m = 0; m < 4; ++m)
#pragma unroll
                for (int n = 0; n < 2; ++n) acc[a][b][m][n] = (f32x4){0.f, 0.f, 0.f, 0.f};
    v8i_t At[4], B0[2], B1[2];
    const int one8 = 0x7f7f7f7f;
    const char* cA = S.A;
    const char* cB = S.b_ptr(cur);
    PG8_STAGE(PG8_SB(0, 0), cB, voffB); PG8_STAGE(PG8_SB(0, 1), cB + hstepB, voffB); PG8_STAGE(PG8_SA(0, 0), cA, vAc[0]); PG8_STAGE(PG8_SA(0, 1), cA, vAc[1]);
    if (wr == 1) PG8_BAR;
    PG8_WAIT_V(2); PG8_BAR;
    PG8_STAGE(PG8_SB(1, 0), cB + kstep, voffB); PG8_STAGE(PG8_SA(1, 0), cA + kstep, vAc[0]); PG8_STAGE(PG8_SB(1, 1), cB + hstepB + kstep, voffB);
    PG8_WAIT_V(6); PG8_BAR;
    for (;;) {
        if constexpr (EpiLds<Epi>::has) { if (wid == 1) E.dma(cur, lds + STAGE_BYTES + 2048 + (ui & 1) * 1024, lane); }
        nxt.e = cur.e;
        const bool has_next = S.next(ui + 1, nxt);
        const char* nB = has_next ? S.b_ptr(nxt) : cB;
        if constexpr (Sched::GATHER) { if (has_next && nxt.rows && wid == 0) __builtin_amdgcn_global_load_lds((const unsigned*)(nxt.rows + lane * 4), (LAS unsigned*)tab, 16, 0, 0); }
        for (int t = 0; t < nt; t += 2) {
            const bool last = (t == nt - 2), relax = (t == 0 && ui > 0);
            const char* a1 = cA + (size_t)(t + 1) * kstep;
            const char* a2 = last ? cA : cA + (size_t)(t + 2) * kstep; const char* b2 = last ? nB : cB + (size_t)(t + 2) * kstep;
            const char* a3 = a2 + kstep; const char* b3 = b2 + kstep;
            unsigned v2[2][2];
            if (last && has_next) a_offsets(nxt, v2, true);
            else {
#pragma unroll
                for (int h = 0; h < 2; ++h)
#pragma unroll
                    for (int i = 0; i < 2; ++i) v2[h][i] = vAc[h][i]; }
            PG8_LDB(B0, 0, 0); PG8_LDB(B1, 0, 1); PG8_SCHED; PG8_LDA(At, 0, 0); PG8_STAGE(PG8_SA(1, 1), a1, vAc[1]);
            PG8_WAIT_VR(relax); PG8_WAIT_L(0); PG8_BAR; PG8_MMA(0, 0, At, B0); PG8_MMA(0, 1, At, B1); PG8_BAR; PG8_SCHED;
            PG8_LDA(At, 0, 1); PG8_STAGE(PG8_SB(0, 0), b2, voffB); PG8_STAGE(PG8_SB(0, 1), b2 + hstepB, voffB); PG8_STAGE(PG8_SA(0, 0), a2, v2[0]);
            PG8_WAIT_VR(relax); PG8_WAIT_L(0); PG8_BAR; PG8_MMA(1, 0, At, B0); PG8_MMA(1, 1, At, B1); PG8_BAR; PG8_SCHED;
            PG8_LDB(B0, 1, 0); PG8_LDB(B1, 1, 1); PG8_SCHED; PG8_LDA(At, 1, 0); PG8_STAGE(PG8_SA(0, 1), a2, v2[1]);
            PG8_WAIT_V(8); PG8_WAIT_L(0); PG8_BAR; PG8_MMA(0, 0, At, B0); PG8_MMA(0, 1, At, B1); PG8_BAR; PG8_SCHED;
            PG8_LDA(At, 1, 1); PG8_STAGE(PG8_SB(1, 0), b3, voffB); PG8_STAGE(PG8_SB(1, 1), b3 + hstepB, voffB); PG8_STAGE(PG8_SA(1, 0), a3, v2[0]);
            PG8_WAIT_V(8); PG8_WAIT_L(0); PG8_BAR; PG8_MMA(1, 0, At, B0); PG8_MMA(1, 1, At, B1); PG8_BAR; PG8_SCHED;
            if (last) {
#pragma unroll
                for (int h = 0; h < 2; ++h)
#pragma unroll
                    for (int i = 0; i < 2; ++i) vAc[h][i] = v2[h][i]; }
        }
        if constexpr (ALIGN_EPI) { if (wr == 0) PG8_BAR; }
        if constexpr (FP8) asm volatile("s_nop 15\n\ts_nop 15" ::: "memory");
        if constexpr (EpiLds<Epi>::has) E(acc, cur, wr, wc, fr, fq, (const LAS float*)(lds + STAGE_BYTES + 2048 + (ui & 1) * 1024)); else E(acc, cur, wr, wc, fr, fq);
        if (!has_next) break;
#pragma unroll
        for (int a = 0; a < 2; ++a)
#pragma unroll
            for (int b = 0; b < 2; ++b)
#pragma unroll
                for (int m = 0; m < 4; ++m)
#pragma unroll
                    for (int n = 0; n < 2; ++n) acc[a][b][m][n] = (f32x4){0.f, 0.f, 0.f, 0.f};
        cur = nxt; cB = nB; ++ui;
        if constexpr (ALIGN_EPI) { if (wr == 1) PG8_BAR; }
    }
    PG8_WAIT_V(0);
    if constexpr (!ALIGN_EPI) { if (wr == 0) PG8_BAR; }
    PG8_BAR;
#undef PG8_SA
#undef PG8_SB
#undef PG8_STAGE
#undef PG8_LDA
#undef PG8_LDB
#undef PG8_MMA
#undef PG8_LO
#undef PG8_HI
#undef PG8_WAIT_V
#undef PG8_WAIT_VR
#undef PG8_WAIT_L
#undef PG8_BAR
#undef PG8_SCHED
}
struct DenseSched { static constexpr bool GATHER = false; const char* A; unsigned lda_b; const char* B; unsigned ldb_b; int rshift; int nM, nN, nwg, G, c;
    DEVI bool next(int i, Unit& u) const {
        const long L = (long)i * G + c; if (L >= nwg) return false;
        int wgid = (int)L; { const int q = nwg / 8, r = nwg % 8, xcd = wgid % 8, off = wgid / 8; wgid = (xcd < r ? xcd * (q + 1) : r * (q + 1) + (xcd - r) * q) + off; }
        const int nig = 8 * nN, gid = wgid / nig, fm = gid * 8, gsz = (nM - fm) < 8 ? (nM - fm) : 8;
        u.pm = fm + ((wgid % nig) % gsz); u.pn = (wgid % nig) / gsz; u.e = 0; u.nvalid = 256; u.rows = nullptr; return true; }
    DEVI const char* b_ptr(const Unit& u) const { return B + (size_t)u.pn * BM * ldb_b; } };
struct MoeSched { static constexpr bool GATHER = true; const char* A; unsigned lda_b; const char* B; unsigned ldb_b; int rshift; size_t estride_b; const int* pre; const unsigned* cnt; const int* list; int NT, total, G, c; bool gather;
    DEVI bool next(int i, Unit& u) const {
        const int cs = (G & 7) == 0 ? (c & 7) * (G >> 3) + (c >> 3) : c;
        const int L = i * G + cs; if (L >= total) return false;
        const int tr = L / NT; u.pn = L % NT; int e = (i > 0 && u.e > 0 && u.e < NEXP && __builtin_amdgcn_readfirstlane(pre[u.e]) <= tr) ? u.e : 0;
        while (e < NEXP - 1 && __builtin_amdgcn_readfirstlane(pre[e + 1]) <= tr) ++e;
        const int mt = tr - __builtin_amdgcn_readfirstlane(pre[e]); u.e = e; u.pm = tr; u.nvalid = min(256, (int)__builtin_amdgcn_readfirstlane((int)cnt[e]) - mt * 256);
        u.rows = gather ? list + (size_t)e * MROWS + mt * 256 : nullptr; return true; }
    DEVI const char* b_ptr(const Unit& u) const { return B + (size_t)u.e * estride_b + (size_t)u.pn * BM * ldb_b; } };
}

struct Epi2P { static constexpr int NST = 16; bf16_t* P; float* G16;
    DEVI void operator()(const f32x4 (&acc)[2][2][4][2], const pg8::Unit& u, int wr, int wc, int fr, int fq) const {
#pragma unroll
        for (int ai = 0; ai < 2; ++ai)
#pragma unroll
            for (int m = 0; m < 4; ++m) { const size_t row = (size_t)u.pm * 256 + ai * 128 + wr * 64 + m * 16 + fr;
#pragma unroll
                for (int bj = 0; bj < 2; ++bj) { const int col = u.pn * 256 + bj * 128 + wc * 32 + 8 * fq; const f32x4 v0 = acc[ai][bj][m][0] * S8_INV, v1 = acc[ai][bj][m][1] * S8_INV;
                    u32x4 w; w.x = pk2(v0[0], v0[1]); w.y = pk2(v0[2], v0[3]); w.z = pk2(v1[0], v1[1]); w.w = pk2(v1[2], v1[3]); *(u32x4*)(P + row * INWP + col) = w;
                    if (col >= O_DB && col < O_DB + 16) { *(f32x4*)(G16 + row * 16 + (col - O_DB)) = v0; *(f32x4*)(G16 + row * 16 + (col - O_DB) + 4) = v1; } } }
    } };
struct Epi2UU { static constexpr int NST = 0; bf16_t* UQ; bf16_t* UKV;
    DEVI void operator()(const f32x4 (&acc)[2][2][4][2], const pg8::Unit& u, int wr, int wc, int fr_in, int fq) const {
        int fr = fr_in; asm volatile("" : "+v"(fr));
#pragma unroll
        for (int ai = 0; ai < 2; ++ai)
#pragma unroll
            for (int m = 0; m < 4; ++m) { const size_t row = (size_t)(unsigned)(u.pm * 256 + ai * 128 + wr * 64 + m * 16 + fr);
#pragma unroll
                for (int bj = 0; bj < 2; ++bj) { const int col = u.pn * 256 + bj * 128 + wc * 32 + 8 * fq; if (col >= 896) continue; const f32x4 v0 = acc[ai][bj][m][0], v1 = acc[ai][bj][m][1];
                    u32x4 w; w.x = pk2(v0[0], v0[1]); w.y = pk2(v0[2], v0[3]); w.z = pk2(v1[0], v1[1]); w.w = pk2(v1[2], v1[3]);
                    if (col < 384) *(u32x4*)(UQ + row * 384 + col) = w; else *(u32x4*)(UKV + row * 512 + (col - 384)) = w; } }
    } };
struct Epi2U { static constexpr int NST = 0; bf16_t* O; int ldo, ncols;
    DEVI void operator()(const f32x4 (&acc)[2][2][4][2], const pg8::Unit& u, int wr, int wc, int fr, int fq) const {
#pragma unroll
        for (int ai = 0; ai < 2; ++ai)
#pragma unroll
            for (int m = 0; m < 4; ++m) { const size_t row = (size_t)u.pm * 256 + ai * 128 + wr * 64 + m * 16 + fr;
#pragma unroll
                for (int bj = 0; bj < 2; ++bj) { const int col = u.pn * 256 + bj * 128 + wc * 32 + 8 * fq; if (col >= ncols) continue; const f32x4 v0 = acc[ai][bj][m][0], v1 = acc[ai][bj][m][1];
                    u32x4 w; w.x = pk2(v0[0], v0[1]); w.y = pk2(v0[2], v0[3]); w.z = pk2(v1[0], v1[1]); w.w = pk2(v1[2], v1[3]); *(u32x4*)(O + row * ldo + col) = w; } }
    } };
struct Epi2Out { static constexpr int NST = 0; const Params* p; int l;
    DEVI void operator()(const f32x4 (&acc)[2][2][4][2], const pg8::Unit& u, int wr, int wc, int fr, int fq) const {
#pragma unroll
        for (int ai = 0; ai < 2; ++ai)
#pragma unroll
            for (int m = 0; m < 4; ++m) { const int row = u.pm * 256 + ai * 128 + wr * 64 + m * 16 + fr;
                const float* g = mod_vec(*p, l, row, 2); bf16_t* o = wsp<bf16_t>(*p, WS_XCUR) + (size_t)row * D;
#pragma unroll
                for (int bj = 0; bj < 2; ++bj) { const int col = u.pn * 256 + bj * 128 + wc * 32 + 8 * fq; f32x4 b0, b1;
                    if (l == 0) { const float* base = row < NLAT ? p->in[I_X] + (size_t)row * D : p->in[I_CTX] + (size_t)(row - NLAT) * D; b0 = *(const f32x4*)(base + col); b1 = *(const f32x4*)(base + col + 4); }
                    else { float t[8]; unpk8(*(const u32x4*)(o + col), t); b0 = (f32x4){t[0], t[1], t[2], t[3]}; b1 = (f32x4){t[4], t[5], t[6], t[7]}; }
                    const f32x4 v0 = b0 + *(const f32x4*)(g + col) * (acc[ai][bj][m][0] * S8_INV), v1 = b1 + *(const f32x4*)(g + col + 4) * (acc[ai][bj][m][1] * S8_INV);
                    u32x4 w; w.x = pk2(v0[0], v0[1]); w.y = pk2(v0[2], v0[3]); w.z = pk2(v1[0], v1[1]); w.w = pk2(v1[2], v1[3]); *(u32x4*)(o + col) = w; } }
    } };
struct Epi2H { static constexpr int NST = 8; unsigned char* H; const float* b1;
    using LdsBias = int;
    DEVI void dma(const pg8::Unit& u, LAS unsigned char* dst, int lane) const {
        const float* bb = b1 + (size_t)u.e * 2048 + u.pn * 128 + (lane < 32 ? lane * 4 : 1024 + (lane - 32) * 4);
        __builtin_amdgcn_global_load_lds((const unsigned*)bb, (LAS unsigned*)dst, 16, 0, 0); }
    DEVI void operator()(const f32x4 (&acc)[2][2][4][2], const pg8::Unit& u, int wr, int wc, int fr, int fq, const LAS float* bt) const {
        const int acol = u.pn * 128 + wc * 32 + 8 * fq;
        f32x2_t bg[2][2], bl[2][2];
#pragma unroll
        for (int n = 0; n < 2; ++n) { const f32x4 g4 = *(const LAS f32x4*)(bt + wc * 32 + 8 * fq + 4 * n), l4 = *(const LAS f32x4*)(bt + 128 + wc * 32 + 8 * fq + 4 * n);
#pragma unroll
            for (int jp = 0; jp < 2; ++jp) { bg[n][jp] = (f32x2_t){g4[2 * jp], g4[2 * jp + 1]}; bl[n][jp] = ((f32x2_t){l4[2 * jp], l4[2 * jp + 1]} + 1.f) * S8_ACT; } }
        const f32x2_t kinv = {S8_INV, S8_INV}, kinva = {S8_INV * S8_ACT, S8_INV * S8_ACT}, kexp = {-1.702f * LOG2E, -1.702f * LOG2E};
#pragma unroll
        for (int ai = 0; ai < 2; ++ai)
#pragma unroll
            for (int m = 0; m < 4; ++m) { const size_t hrow = (size_t)u.pm * 256 + ai * 128 + wr * 64 + m * 16 + fr; int w[2] = {0, 0};
#pragma unroll
                for (int n = 0; n < 2; ++n)
#pragma unroll
                    for (int jp = 0; jp < 2; ++jp) {
                        f32x2_t g = __builtin_elementwise_fma((f32x2_t){acc[ai][0][m][n][2 * jp], acc[ai][0][m][n][2 * jp + 1]}, kinv, bg[n][jp]);
                        g.x = fminf(g.x, 7.f); g.y = fminf(g.y, 7.f);
                        f32x2_t t = g * kexp; t.x = __builtin_amdgcn_exp2f(t.x); t.y = __builtin_amdgcn_exp2f(t.y);
                        t = t + 1.f; t.x = __builtin_amdgcn_rcpf(t.x); t.y = __builtin_amdgcn_rcpf(t.y);
                        f32x2_t li = __builtin_elementwise_fma((f32x2_t){acc[ai][1][m][n][2 * jp], acc[ai][1][m][n][2 * jp + 1]}, kinva, bl[n][jp]);
                        li.x = __builtin_amdgcn_fmed3f(li.x, -6.f * S8_ACT, 8.f * S8_ACT); li.y = __builtin_amdgcn_fmed3f(li.y, -6.f * S8_ACT, 8.f * S8_ACT);
                        const f32x2_t o = (g * t) * li;
                        if (jp == 0) w[n] = __builtin_amdgcn_cvt_pk_fp8_f32(o.x, o.y, w[n], false); else w[n] = __builtin_amdgcn_cvt_pk_fp8_f32(o.x, o.y, w[n], true); }
                u32x2 w2; w2.x = (unsigned)w[0]; w2.y = (unsigned)w[1]; *(u32x2*)(H + hrow * DEXP + acol) = w2; }
    } };
struct Epi2Y { static constexpr int NST = 16; static constexpr int DUMPBACK = (int)((WS_YEXP - WS_H - (size_t)HROWS_MAX * DEXP) / D); static_assert((size_t)DUMPBACK * D == WS_YEXP - WS_H - (size_t)HROWS_MAX * DEXP && DUMPBACK >= 256, "dump rows"); unsigned char* Y;   const float* b2; const int* list; const int* pre;
    using LdsBias = int;
    DEVI void dma(const pg8::Unit& u, LAS unsigned char* dst, int lane) const {
        __builtin_amdgcn_global_load_lds((const unsigned*)(b2 + (size_t)u.e * D + u.pn * 256 + lane * 4), (LAS unsigned*)dst, 16, 0, 0);
        __builtin_amdgcn_global_load_lds((const unsigned*)(list + (size_t)u.e * MROWS + (u.pm - __builtin_amdgcn_readfirstlane(pre[u.e])) * 256 + lane * 4), (LAS unsigned*)(dst + 2048), 16, 0, 0); }
    DEVI void operator()(const f32x4 (&acc)[2][2][4][2], const pg8::Unit& u, int wr, int wc, int fr, int fq, const LAS float* bt) const {
        f32x4 bias[2][2]; int yr[2][4];
#pragma unroll
        for (int bj = 0; bj < 2; ++bj)
#pragma unroll
            for (int n = 0; n < 2; ++n) bias[bj][n] = *(const LAS f32x4*)(bt + bj * 128 + wc * 32 + 8 * fq + 4 * n);
#pragma unroll
        for (int ai = 0; ai < 2; ++ai)
#pragma unroll
            for (int m = 0; m < 4; ++m) yr[ai][m] = ((const LAS int*)(bt + 512))[ai * 128 + wr * 64 + m * 16 + fr];
#pragma unroll
        for (int ai = 0; ai < 2; ++ai)
#pragma unroll
            for (int m = 0; m < 4; ++m) { const int r = ai * 128 + wr * 64 + m * 16 + fr; const int yrow = r < u.nvalid ? yr[ai][m] : r - DUMPBACK;
#pragma unroll
                for (int bj = 0; bj < 2; ++bj) { const int col = u.pn * 256 + bj * 128 + wc * 32 + 8 * fq; const f32x4 v0 = (acc[ai][bj][m][0] * S8_INV + bias[bj][0]) * S8_Y, v1 = (acc[ai][bj][m][1] * S8_INV + bias[bj][1]) * S8_Y;
                    u32x2 w; w.x = pk4_fp8(v0[0], v0[1], v0[2], v0[3]); w.y = pk4_fp8(v1[0], v1[1], v1[2], v1[3]); *(u32x2*)(Y + (ptrdiff_t)yrow * D + col) = w; } }
    } };

DEVI void ph_inproj(const Params& p, char* lds, int l) {
    pg8::DenseSched S; S.A = (const char*)wsp<unsigned char>(p, WS_HB); S.lda_b = D; S.B = (const char*)(wsp<unsigned char>(p, WS_WIN) + (size_t)l * INWP * D); S.ldb_b = D; S.rshift = 0;
    S.nM = MROWS / 256; S.nN = INWP / 256; S.nwg = S.nM * S.nN; S.G = gridDim.x; S.c = blockIdx.x;
    Epi2P E{wsp<bf16_t>(p, WS_P), wsp<float>(p, WS_G16)};
    pg8::gemm_phase<true, true>((LAS unsigned char*)(LAS char*)lds, D, S, E);
}
DEVI void ph_outproj(const Params& p, char* lds, int l) {
    pg8::DenseSched S; S.A = (const char*)wsp<unsigned char>(p, WS_Y); S.lda_b = D; S.B = (const char*)(wsp<unsigned char>(p, WS_WOUT) + (size_t)l * D * D); S.ldb_b = D; S.rshift = 0;
    S.nM = (l == 0 ? MROWS : NLAT) / 256; S.nN = D / 256; S.nwg = S.nM * S.nN; S.G = gridDim.x; S.c = blockIdx.x;
    Epi2Out E{&p, l};
    pg8::gemm_phase<true, true>((LAS unsigned char*)(LAS char*)lds, D, S, E);
}

DEVI float dppf(float v, int ctrl_sel) {
    const int x = __builtin_bit_cast(int, v);
    const int r = ctrl_sel == 0 ? __builtin_amdgcn_update_dpp(0, x, 0xB1, 0xF, 0xF, true) : ctrl_sel == 1 ? __builtin_amdgcn_update_dpp(0, x, 0x4E, 0xF, 0xF, true) : __builtin_amdgcn_update_dpp(0, x, 0x141, 0xF, 0xF, true);
    return __builtin_bit_cast(float, r); }
DEVI float sum8(float v) { v += dppf(v, 0); v += dppf(v, 1); v += dppf(v, 2); return v; }
DEVI u32x4 pk8(const float* y) { u32x4 w; w.x = pk2(y[0], y[1]); w.y = pk2(y[2], y[3]); w.z = pk2(y[4], y[5]); w.w = pk2(y[6], y[7]); return w; }
DEVI unsigned elem16(const u32x4& w, int j) { const unsigned x = (j >> 1) == 0 ? w.x : (j >> 1) == 1 ? w.y : (j >> 1) == 2 ? w.z : w.w; return (j & 1) ? (x >> 16) : (x & 0xffffu); }
DEVI void stT8(bf16_t* dstT, const u32x4 (&w)[8]) {
#pragma unroll
    for (int j = 0; j < 8; ++j) { u32x4 o; o.x = elem16(w[0], j) | (elem16(w[1], j) << 16); o.y = elem16(w[2], j) | (elem16(w[3], j) << 16); o.z = elem16(w[4], j) | (elem16(w[5], j) << 16); o.w = elem16(w[6], j) | (elem16(w[7], j) << 16);
        *(u32x4*)(dstT + (size_t)j * KV) = o; } }
DEVI void ld8(const bf16_t* src, float* v) { const u32x4 w = *(const u32x4*)src;
    v[0] = __builtin_bit_cast(float, w.x << 16); v[1] = __builtin_bit_cast(float, w.x & 0xffff0000u); v[2] = __builtin_bit_cast(float, w.y << 16); v[3] = __builtin_bit_cast(float, w.y & 0xffff0000u);
    v[4] = __builtin_bit_cast(float, w.z << 16); v[5] = __builtin_bit_cast(float, w.z & 0xffff0000u); v[6] = __builtin_bit_cast(float, w.w << 16); v[7] = __builtin_bit_cast(float, w.w & 0xffff0000u); }
DEVI void st8(bf16_t* dst, const float* y) { u32x4 w; w.x = pk2(y[0], y[1]); w.y = pk2(y[2], y[3]); w.z = pk2(y[4], y[5]); w.w = pk2(y[6], y[7]); *(u32x4*)dst = w; }
template <int N> DEVI void stT(bf16_t* dstT  , const float* y) {
#pragma unroll
    for (int d = 0; d < N; ++d) dstT[(size_t)d * KV] = f2bf(y[d]); }
DEVI void store_vt(bf16_t* sc, int lane, bf16_t* dstT  ) {
#pragma unroll
    for (int c = 0; c < 8; ++c) { u32x4 w; unsigned t[4];
#pragma unroll
        for (int j = 0; j < 4; ++j) t[j] = (unsigned)sc[(c * 8 + 2 * j) * 66 + lane] | ((unsigned)sc[(c * 8 + 2 * j + 1) * 66 + lane] << 16);
        w.x = t[0]; w.y = t[1]; w.z = t[2]; w.w = t[3]; *(u32x4*)(dstT + (size_t)lane * KV + c * 8) = w; }
}

#ifndef SUBDUP
#define SUBDUP 0
#endif
DEVI void ph_post(const Params& p, char* lds, int l) {
    { pg8::DenseSched S; S.A = (const char*)(wsp<bf16_t>(p, WS_P) + O_CQ); S.lda_b = INWP * 2; S.B = (const char*)(wsp<bf16_t>(p, WS_WUQ) + (size_t)l * 1024 * 384); S.ldb_b = 384 * 2; S.rshift = 0;
      S.nM = MROWS / 256; S.nN = 4; S.nwg = S.nM * S.nN; S.G = gridDim.x; S.c = blockIdx.x;
      Epi2UU E{wsp<bf16_t>(p, WS_UQ), wsp<bf16_t>(p, WS_UKV)};
      pg8::gemm_phase<false, true>((LAS unsigned char*)(LAS char*)lds, 384 * 2, S, E); }
    __syncthreads();
    const int tid = tid_fresh(), lane = tid & 63, wid = __builtin_amdgcn_readfirstlane(tid >> 6);
    const bf16_t* P = wsp<bf16_t>(p, WS_P);
    float* gt = (float*)(lds + 40960);
    float* cw = gt + 256;
    for (int i = tid; i < 256; i += NTHREADS) { const int w4 = i >> 6, d = i & 63; gt[i] = p.in[w4 == 0 ? I_NAQG : w4 == 1 ? I_NAKG : w4 == 2 ? I_GQG : I_GKG][l * 64 + d] * ((w4 & 1) ? 1.f : 0.125f * LOG2E); }
    for (int i = tid; i < 3840; i += NTHREADS) cw[i] = p.in[I_DCONV][(size_t)l * 3840 + i];
    __syncthreads();
    constexpr int NJOB = 33, NITEM = NB * NCH * NJOB;
    for (int it0 = blockIdx.x * 8 + wid; it0 < NITEM; it0 += gridDim.x * 8) {
        const int job = it0 % NJOB, bb = it0 / NJOB, b = bb / NCH, blk = bb % NCH, pos0 = blk * 64, row0 = bp2row(b, pos0);
        int ln = lane; asm volatile("" : "+v"(ln));
        const int tk = ln >> 3, ch = ln & 7; const bool lat = pos0 < SEQ;
        const size_t prow = (size_t)(row0 + tk * 8) * INWP + ch * 8;
        const int posl = pos0 + tk * 8;
        if (job < 8 || (job >= 12 && job < 18)) {
            const bool na = job < 8; const bool isq = na ? job < 4 : job < 16; const int h = na ? (job & 3) : (isq ? job - 12 : job - 16);
            const int off = (na ? (isq ? O_NAQ : O_NAK) : (isq ? O_GQ : O_GK)) + h * 64; const float* gp = gt + ((na ? 0 : 2) + (isq ? 0 : 1)) * 64 + ch * 8;
            float g[8];
#pragma unroll
            for (int d = 0; d < 8; ++d) g[d] = gp[d];
            u32x4 w[8];
#pragma unroll
            for (int it = 0; it < 8; ++it) w[it] = *(const u32x4*)(P + prow + (size_t)it * INWP + off);
            bf16_t* dst = wsp<bf16_t>(p, na ? (isq ? WS_QNA : WS_KNA) : (isq ? WS_QG : WS_KG)) + ((size_t)(b * ((na || isq) ? 4 : 2) + h) * KV + posl) * 64 + ch * 8;
            const bool rope = !na && lat;
            f32x4 rt[8][2];
            if (rope) {
#pragma unroll
                for (int it = 0; it < 8; ++it) { const float* cs = wsp<float>(p, WS_TRG) + (size_t)(posl + it) * 64 + ch * 8; rt[it][0] = *(const f32x4*)cs; rt[it][1] = *(const f32x4*)(cs + 4); } }
            asm volatile("" ::: "memory");
#pragma unroll
            for (int it = 0; it < 8; ++it) { float v[8]; unpk8(w[it], v); float ss = 0.f;
#pragma unroll
                for (int d = 0; d < 8; ++d) ss += v[d] * v[d];
                const float r = rsqrtf(sum8(ss) * (1.f / 64.f) + EPS);
#pragma unroll
                for (int d = 0; d < 8; ++d) v[d] *= r * g[d];
                if (rope) { const f32x4 t0 = rt[it][0], t1 = rt[it][1];
                    const float a0 = v[0], a1 = v[1], b0 = v[2], b1 = v[3], c0 = v[4], c1 = v[5], d0 = v[6], d1 = v[7];
                    v[0] = a0 * t0[0] - a1 * t0[1]; v[1] = a0 * t0[1] + a1 * t0[0]; v[2] = b0 * t0[2] - b1 * t0[3]; v[3] = b0 * t0[3] + b1 * t0[2];
                    v[4] = c0 * t1[0] - c1 * t1[1]; v[5] = c0 * t1[1] + c1 * t1[0]; v[6] = d0 * t1[2] - d1 * t1[3]; v[7] = d0 * t1[3] + d1 * t1[2]; }
                *(u32x4*)(dst + (size_t)it * 64) = pk8(v); }
        } else if (job < 12 || (job >= 18 && job < 20)) {
            const bool na = job < 12; const int h = na ? job - 8 : job - 18, off = (na ? O_NAV : O_GV) + h * 64;
            u32x4 w[8];
#pragma unroll
            for (int it = 0; it < 8; ++it) w[it] = *(const u32x4*)(P + prow + (size_t)it * INWP + off);
            stT8(wsp<bf16_t>(p, na ? WS_VTNA : WS_VTG) + ((size_t)(b * (na ? 4 : 2) + h) * 64 + ch * 8) * KV + posl, w);
        } else if (job < 32) {
            const int which = (job - 20) >> 2, h = (job - 20) & 3, ch0 = which * 256 + h * 64;
            const int seq0 = lat ? 0 : SEQ, seqn = lat ? SEQ : CTX, tl0 = posl - seq0 - 2;
            u32x4 xw[12];
#pragma unroll
            for (int q = 0; q < 12; ++q) { const int tt = tl0 + q; xw[q] = (tt >= 0 && tt < seqn) ? *(const u32x4*)(P + prow + (long)(q - 2) * INWP + O_DQ + ch0) : (u32x4){0u, 0u, 0u, 0u}; }
            float tw[5][8];
#pragma unroll
            for (int j = 0; j < 5; ++j)
#pragma unroll
                for (int d = 0; d < 8; ++d) tw[j][d] = cw[j * 768 + ch0 + ch * 8 + d];
            bf16_t* dst = wsp<bf16_t>(p, which == 0 ? WS_QD : which == 1 ? WS_KD : WS_VD) + ((size_t)(b * 4 + h) * KV + posl) * 64 + ch * 8;
            u32x4 ow[8];
#pragma unroll
            for (int it = 0; it < 8; ++it) { float a[8];
#pragma unroll
                for (int d = 0; d < 8; ++d) a[d] = 0.f;
#pragma unroll
                for (int j = 0; j < 5; ++j) { float x[8]; unpk8(xw[it + j], x);
#pragma unroll
                    for (int d = 0; d < 8; ++d) a[d] += x[d] * tw[j][d]; }
                float ss = 0.f;
#pragma unroll
                for (int d = 0; d < 8; ++d) { a[d] = siluf(a[d]); ss += a[d] * a[d]; }
                if (which < 2) { const float r = rsqrtf(sum8(ss) + EPS) * (which == 0 ? 0.125f : 1.f);
#pragma unroll
                    for (int d = 0; d < 8; ++d) a[d] *= r; }
                ow[it] = pk8(a); *(u32x4*)(dst + (size_t)it * 64) = ow[it]; }
            if (which > 0) stT8(wsp<bf16_t>(p, which == 1 ? WS_KTD : WS_VTD) + ((size_t)(b * 4 + h) * 64 + ch * 8) * KV + posl, ow);
        } else {
            const float* g16 = wsp<float>(p, WS_G16) + (size_t)(row0 + ln) * 16;
#pragma unroll
            for (int dh = 0; dh < 8; ++dh) { const int dir = dh >> 2, h = dh & 3; const float beta = sigmoidf(g16[dh]);
                const float x = g16[8 + dh] + p.in[I_DDT][l * 8 + dh]; const float sp = x > 20.f ? x : log1pf(__expf(x));
                const float g = -__expf(p.in[I_DALOG][l * 8 + dh]) * sp; const size_t o = ((size_t)((b * 4 + h) * 2 + dir)) * KV + pos0 + ln;
                wsp<float>(p, WS_DG)[o] = g; wsp<float>(p, WS_DBETA)[o] = beta; }
        }
    }
}

DEVI void mla_rows(const Params& p, const float* gq, int l, int lane) {
    const bf16_t* P = wsp<bf16_t>(p, WS_P); const float* gk = gq + 96;
    constexpr int NITEM = NB * NCH * 8;
    unsigned* qh = wsp<unsigned>(p, WS_CTL) + CW_MLAQ + l * 64;
    for (;;) {
        int it0 = 0; if (lane == 0) it0 = (int)atomicAdd(qh, 1u);
        it0 = __builtin_amdgcn_readfirstlane(it0);
        if (it0 >= NITEM) break;
        int job = it0 & 7; asm volatile("" : "+v"(job));
        const int bb = it0 >> 3, b = bb / NCH, blk = bb % NCH, pos0 = blk * 64, row0 = bp2row(b, pos0), h = job & 3; const bool lat = pos0 < SEQ;
        int ln = lane; asm volatile("" : "+v"(ln));
        const int tk = ln >> 3, ch = ln & 7; const bool isq = job < 4, tail = ch < 4;
        const size_t rowl = (size_t)(row0 + tk * 8); const int posl = pos0 + tk * 8;
        const float* gsrc = (isq ? gq : gk); float g0[8], g1[8];
#pragma unroll
        for (int d = 0; d < 8; ++d) { g0[d] = gsrc[ch * 8 + d]; g1[d] = tail ? gsrc[64 + ch * 8 + d] : 0.f; }
        const float qs = isq ? 0.10206207261596575f * LOG2E : 1.f;
        bf16_t* dst = wsp<bf16_t>(p, isq ? WS_QM : WS_KM) + ((size_t)(b * 4 + h) * KV + posl) * 96 + ch * 8;
        u32x4 vw[8];
#pragma unroll
        for (int hb = 0; hb < 2; ++hb) {
            u32x4 c0[4], c1[4], c2[4], c3[4], u0[4], u1[4]; f32x4 rt0[4], rt1[4];
#pragma unroll
            for (int j = 0; j < 4; ++j) { const int it = hb * 4 + j; const size_t row = rowl + it;
                const bf16_t* cp = P + row * INWP + (isq ? O_CQ : O_CKV) + ch * 8;
                c0[j] = *(const u32x4*)cp; c1[j] = *(const u32x4*)(cp + 64); c2[j] = (u32x4){0u, 0u, 0u, 0u}; c3[j] = c2[j];
                if (isq) { c2[j] = *(const u32x4*)(cp + 128); c3[j] = *(const u32x4*)(cp + 192); }
                const bf16_t* u96 = isq ? wsp<bf16_t>(p, WS_UQ) + row * 384 + h * 96 : wsp<bf16_t>(p, WS_UKV) + row * 512 + h * 128;
                u0[j] = *(const u32x4*)(u96 + ch * 8);
                u1[j] = (u32x4){0u, 0u, 0u, 0u};
                if (tail) u1[j] = isq ? *(const u32x4*)(u96 + 64 + ch * 8) : *(const u32x4*)(P + row * INWP + O_KPE + ch * 8);
                if (!isq) vw[it] = *(const u32x4*)(u96 + 64 + ch * 8);
                rt0[j] = (f32x4){0.f, 0.f, 0.f, 0.f}; rt1[j] = rt0[j];
                if (lat && tail) { const float* tc = wsp<float>(p, WS_TRM) + (size_t)(posl + it) * 32 + ch * 8; rt0[j] = *(const f32x4*)tc; rt1[j] = *(const f32x4*)(tc + 4); } }
            asm volatile("" ::: "memory");
#pragma unroll
            for (int j = 0; j < 4; ++j) { const int it = hb * 4 + j;
                float x[8], cs = 0.f;
                unpk8(c0[j], x);
#pragma unroll
                for (int d = 0; d < 8; ++d) cs += x[d] * x[d];
                unpk8(c1[j], x);
#pragma unroll
                for (int d = 0; d < 8; ++d) cs += x[d] * x[d];
                unpk8(c2[j], x);
#pragma unroll
                for (int d = 0; d < 8; ++d) cs += x[d] * x[d];
                unpk8(c3[j], x);
#pragma unroll
                for (int d = 0; d < 8; ++d) cs += x[d] * x[d];
                const float ss = rsqrtf(sum8(cs) * (isq ? 1.f / 256.f : 1.f / 128.f) + EPS);
                float y0[8], y1[8]; unpk8(u0[j], y0); unpk8(u1[j], y1); const float f1 = isq ? ss : 1.f; float s2 = 0.f;
#pragma unroll
                for (int d = 0; d < 8; ++d) { y0[d] *= ss; y1[d] *= f1; s2 += y0[d] * y0[d] + y1[d] * y1[d]; }
                const float r = rsqrtf(sum8(s2) * (1.f / 96.f) + EPS) * qs;
#pragma unroll
                for (int d = 0; d < 8; ++d) { y0[d] *= r * g0[d]; y1[d] *= r * g1[d]; }
                if (lat && tail) { const f32x4 t0 = rt0[j], t1 = rt1[j];
                    const float a0 = y1[0], a1 = y1[1], b0 = y1[2], b1 = y1[3], e0 = y1[4], e1 = y1[5], d0 = y1[6], d1 = y1[7];
                    y1[0] = a0 * t0[0] - a1 * t0[1]; y1[1] = a0 * t0[1] + a1 * t0[0]; y1[2] = b0 * t0[2] - b1 * t0[3]; y1[3] = b0 * t0[3] + b1 * t0[2];
                    y1[4] = e0 * t1[0] - e1 * t1[1]; y1[5] = e0 * t1[1] + e1 * t1[0]; y1[6] = d0 * t1[2] - d1 * t1[3]; y1[7] = d0 * t1[3] + d1 * t1[2]; }
                *(u32x4*)(dst + (size_t)it * 96) = pk8(y0);
                if (tail) *(u32x4*)(dst + (size_t)it * 96 + 64) = pk8(y1);
                if (!isq) { float v[8]; unpk8(vw[it], v);
#pragma unroll
                    for (int d = 0; d < 8; ++d) v[d] *= ss;
                    vw[it] = pk8(v); } } }
        if (!isq) stT8(wsp<bf16_t>(p, WS_VTM) + ((size_t)(b * 4 + h) * 64 + ch * 8) * KV + posl, vw);
    }
}

DEVI void mm_tile(f32x16& acc, const bf16_t* A, int lda, const bf16_t* Bt, int ldb, int mb, int nb, int lane) {
    const int r32 = lane & 31, hh = lane >> 5;
#pragma unroll
    for (int ks = 0; ks < 4; ++ks) { const bf16x8 a = *(const bf16x8*)(A + (mb * 32 + r32) * lda + ks * 16 + 8 * hh), b = *(const bf16x8*)(Bt + (nb * 32 + r32) * ldb + ks * 16 + 8 * hh);
        acc = __builtin_amdgcn_mfma_f32_32x32x16_bf16(a, b, acc, 0, 0, 0); }
}
DEVI int crow(int reg, int hh) { return (reg & 3) + 8 * (reg >> 2) + 4 * hh; }
DEVI void tile_store_t(const f32x16& acc, bf16_t* dst, int ld, int mb, int nb, int lane) {
    const int r32 = lane & 31, hh = lane >> 5;
#pragma unroll
    for (int g = 0; g < 4; ++g) { u32x2 w; w.x = pk2(acc[4 * g], acc[4 * g + 1]); w.y = pk2(acc[4 * g + 2], acc[4 * g + 3]); *(u32x2*)(dst + (size_t)(nb * 32 + r32) * ld + mb * 32 + 8 * g + 4 * hh) = w; }
}
constexpr size_t DN_ITEM = 4096;

constexpr int DNW_LDS = 64 * 68 * 4 + 4 * 64 * 4;
DEVI int swz(int r, int c8) { return r * 64 + ((c8 ^ (r & 7)) << 3); }
DEVI bf16x8 frag_lds(const bf16_t* M, int row, int ks, int hh) { return *(const bf16x8*)(M + swz(row, ks * 2 + hh)); }
DEVI void tile_store_t_swz(const f32x16& acc, bf16_t* M, int mb, int nb, int lane) {
    const int R = nb * 32 + (lane & 31), hh = lane >> 5;
#pragma unroll
    for (int g = 0; g < 4; ++g) { u32x2 w; w.x = pk2(acc[4 * g], acc[4 * g + 1]); w.y = pk2(acc[4 * g + 2], acc[4 * g + 3]); *(u32x2*)(M + swz(R, mb * 4 + g) + 4 * hh) = w; }
}
DEVI void dn_chunk_wave(const Params& p, char* ldsw, int it, int lane_in) {
    int lane = lane_in; asm volatile("" : "+v"(lane));
    const int r32 = lane & 31, hh = lane >> 5;
    float* AT = (float*)ldsw; bf16_t* R1 = (bf16_t*)ldsw; bf16_t* R2 = R1 + 4096;
    float* gcn = (float*)(ldsw + 64 * 68 * 4); float* be = gcn + 64; float* dec = be + 64; float* eg = dec + 64;
    const int blk = it % NCH, dir = (it / NCH) & 1, bh = it / (NCH * 2), pos0 = blk * 64;
    float egl;
    { const int i = dir ? 63 - lane : lane; const size_t go = ((size_t)(bh * 2 + dir)) * KV + pos0 + i; float g = wsp<float>(p, WS_DG)[go];
#pragma unroll
      for (int o = 1; o < 64; o <<= 1) { const float t = __shfl_up(g, o); if (lane >= o) g += t; }
      const float gl = __shfl(g, 63); gcn[i] = g; be[i] = wsp<float>(p, WS_DBETA)[go]; dec[i] = __expf(gl - g); eg[i] = __expf(g); egl = __expf(gl); }
    bf16x8 kr[2][4];
#pragma unroll
    for (int mb = 0; mb < 2; ++mb)
#pragma unroll
        for (int ks = 0; ks < 4; ++ks) kr[mb][ks] = *(const bf16x8*)(wsp<bf16_t>(p, WS_KD) + ((size_t)bh * KV + pos0 + mb * 32 + r32) * 64 + ks * 16 + 8 * hh);
#pragma unroll
    for (int mb = 0; mb < 2; ++mb)
#pragma unroll
        for (int nb = 0; nb < 2; ++nb) { f32x16 acc;
#pragma unroll
            for (int q = 0; q < 16; ++q) acc[q] = 0.f;
#pragma unroll
            for (int ks = 0; ks < 4; ++ks) acc = __builtin_amdgcn_mfma_f32_32x32x16_bf16(kr[mb][ks], kr[nb][ks], acc, 0, 0, 0);
            const int j = nb * 32 + r32, sj = dir ? 63 - j : j; const float gcj = gcn[j];
#pragma unroll
            for (int q = 0; q < 16; ++q) { const int i = mb * 32 + crow(q, hh), si = dir ? 63 - i : i; AT[sj * 68 + si] = sj < si ? acc[q] * be[i] * __expf(gcn[i] - gcj) : 0.f; } }
    asm volatile("" ::: "memory");
    f32x2_t y2[32];
#pragma unroll
    for (int k = 0; k < 32; ++k) y2[k] = (f32x2_t){0.f, 0.f};
#pragma unroll
    for (int j = 63; j >= 0; --j) {
        unsigned rowoff = (unsigned)(j * 68 * 4); int lj = lane; asm volatile("" : "+v"(rowoff), "+v"(lj) : "v"(y2[j < 63 ? (j + 1) >> 1 : 31]));
        f32x2_t a0 = (f32x2_t){(lj == j) ? 1.f : 0.f, 0.f}, a1 = (f32x2_t){0.f, 0.f};
#pragma unroll
        for (int i = 60; i >= ((j + 1) & ~3); i -= 4) { if (i > 63) continue; const f32x4 a = *(const f32x4*)((const float*)((const char*)AT + rowoff) + i);
            a0 -= y2[i >> 1] * (f32x2_t){a[0], a[1]}; a1 -= y2[(i >> 1) + 1] * (f32x2_t){a[2], a[3]};
            if ((i & 31) == 0) asm volatile("" : "+v"(rowoff) : "v"(a0), "v"(a1)); }
        const float yj = (a0[0] + a0[1]) + (a1[0] + a1[1]);
        if (j & 1) y2[j >> 1][1] = yj; else y2[j >> 1][0] = yj; }
    float y[64];
#pragma unroll
    for (int k = 0; k < 32; ++k) { y[2 * k] = y2[k][0]; y[2 * k + 1] = y2[k][1]; }
    const int inat = dir ? 63 - lane : lane;
#define DN_WRITE_T(WITH_EG) do { _Pragma("unroll") for (int c8 = 0; c8 < 8; ++c8) { float v[8]; \
        _Pragma("unroll") for (int t = 0; t < 8; ++t) { const int j = c8 * 8 + t; const float yy = dir ? y[63 - j] : y[j]; v[t] = yy * be[j] * ((WITH_EG) ? eg[j] : 1.f); } \
        *(u32x4*)(R1 + swz(inat, c8)) = pk8(v); } } while (0)
    DN_WRITE_T(false);
    const size_t mo = (size_t)it * DN_ITEM;
    asm volatile("" ::: "memory");
    bf16x8 vt[2][4];
#pragma unroll
    for (int mb = 0; mb < 2; ++mb)
#pragma unroll
        for (int ks = 0; ks < 4; ++ks) vt[mb][ks] = *(const bf16x8*)(wsp<bf16_t>(p, WS_VTD) + ((size_t)bh * 64 + mb * 32 + r32) * KV + pos0 + ks * 16 + 8 * hh);
#pragma unroll
    for (int mb = 0; mb < 2; ++mb)
#pragma unroll
        for (int nb = 0; nb < 2; ++nb) { f32x16 acc;
#pragma unroll
            for (int q = 0; q < 16; ++q) acc[q] = 0.f;
#pragma unroll
            for (int ks = 0; ks < 4; ++ks) acc = __builtin_amdgcn_mfma_f32_32x32x16_bf16(frag_lds(R1, mb * 32 + r32, ks, hh), vt[nb][ks], acc, 0, 0, 0);
            float* U = wsp<float>(p, WS_DU) + mo + (size_t)(mb * 2 + nb) * 1024;
#pragma unroll
            for (int q = 0; q < 16; ++q) { U[q * 64 + lane] = acc[q]; acc[q] *= dec[mb * 32 + crow(q, hh)]; }
            tile_store_t_swz(acc, R2, mb, nb, lane); }
    DN_WRITE_T(true);
    asm volatile("" ::: "memory");
    bf16x8 kt[2][4];
#pragma unroll
    for (int mb = 0; mb < 2; ++mb)
#pragma unroll
        for (int ks = 0; ks < 4; ++ks) kt[mb][ks] = *(const bf16x8*)(wsp<bf16_t>(p, WS_KTD) + ((size_t)bh * 64 + mb * 32 + r32) * KV + pos0 + ks * 16 + 8 * hh);
#pragma unroll
    for (int mb = 0; mb < 2; ++mb)
#pragma unroll
        for (int nb = 0; nb < 2; ++nb) { f32x16 acc;
#pragma unroll
            for (int q = 0; q < 16; ++q) acc[q] = 0.f;
#pragma unroll
            for (int ks = 0; ks < 4; ++ks) acc = __builtin_amdgcn_mfma_f32_32x32x16_bf16(kt[mb][ks], frag_lds(R2, nb * 32 + r32, ks, hh), acc, 0, 0, 0);
            float* Nn = wsp<float>(p, WS_DN) + mo + (size_t)(mb * 2 + nb) * 1024;
#pragma unroll
            for (int q = 0; q < 16; ++q) Nn[q * 64 + lane] = acc[q]; }
#pragma unroll
    for (int mb = 0; mb < 2; ++mb)
#pragma unroll
        for (int nb = 0; nb < 2; ++nb) { f32x16 acc;
#pragma unroll
            for (int q = 0; q < 16; ++q) acc[q] = 0.f;
#pragma unroll
            for (int ks = 0; ks < 4; ++ks) acc = __builtin_amdgcn_mfma_f32_32x32x16_bf16(frag_lds(R1, mb * 32 + r32, ks, hh), kt[nb][ks], acc, 0, 0, 0);
#pragma unroll
            for (int q = 0; q < 16; ++q) acc[q] *= dec[mb * 32 + crow(q, hh)];
            tile_store_t_swz(acc, R2, mb, nb, lane);
#pragma unroll
            for (int q = 0; q < 16; ++q) acc[q] = 0.f;
#pragma unroll
            for (int ks = 0; ks < 4; ++ks) acc = __builtin_amdgcn_mfma_f32_32x32x16_bf16(kt[mb][ks], frag_lds(R1, nb * 32 + r32, ks, hh), acc, 0, 0, 0);
            tile_store_t(acc, (bf16_t*)(wsp<float>(p, WS_DW) + mo), 64, mb, nb, lane); }
#pragma unroll
    for (int mb = 0; mb < 2; ++mb)
#pragma unroll
        for (int nb = 0; nb < 2; ++nb) { f32x16 acc;
#pragma unroll
            for (int q = 0; q < 16; ++q) acc[q] = 0.f;
#pragma unroll
            for (int ks = 0; ks < 4; ++ks) acc = __builtin_amdgcn_mfma_f32_32x32x16_bf16(frag_lds(R2, mb * 32 + r32, ks, hh), kt[nb][ks], acc, 0, 0, 0);
#pragma unroll
            for (int q = 0; q < 16; ++q) acc[q] = ((mb * 32 + crow(q, hh)) == (nb * 32 + r32) ? egl : 0.f) - acc[q];
            tile_store_t(acc, (bf16_t*)(wsp<float>(p, WS_DM) + mo), 64, mb, nb, lane); }
}
#undef DN_WRITE_T
DEVI void dn_chunk_local(const Params& p, char* lds, int l) {
    const int tid = tid_fresh(), lane = tid & 63, wid = __builtin_amdgcn_readfirstlane(tid >> 6);
    const int NITEM = NB * 4 * 2 * NCH;
    float* gq = (float*)(lds + 8 * DNW_LDS);
    __syncthreads();
    for (int i = tid; i < 192; i += NTHREADS) gq[i] = i < 96 ? p.in[I_MQNG][l * 96 + i] : p.in[I_MKNG][l * 96 + i - 96];
    __syncthreads();
#pragma unroll 1
    for (int it = blockIdx.x * 8 + wid; it < NITEM; it += gridDim.x * 8) dn_chunk_wave(p, lds + wid * DNW_LDS, it, lane);
    mla_rows(p, gq, l, lane);
    __syncthreads();
}

DEVI void dn_scan_wave(const Params& p, char* lds_wave, int item, int lane) {
    const int nb = item & 1, dir = (item >> 1) & 1, bh = item >> 2, r32 = lane & 31, hh = lane >> 5;
    bf16_t* St = (bf16_t*)lds_wave;
    u32x2 pk[2][4];
#pragma unroll
    for (int mb = 0; mb < 2; ++mb)
#pragma unroll
        for (int g = 0; g < 4; ++g) { pk[mb][g] = (u32x2){0u, 0u}; *(u32x2*)(St + r32 * 72 + mb * 32 + 8 * g + 4 * hh) = pk[mb][g]; }
    bf16x8 am[2][4], amn[2][4]; f32x16 nn[2], nnn[2];
    auto blk_of = [&](int step) { return dir ? 67 - step : (step < 4 ? 64 + step : step - 4); };
    auto load = [&](int step, bf16x8 (&a)[2][4], f32x16 (&n)[2]) { const size_t mo = ((size_t)((bh * 2 + dir) * NCH + blk_of(step))) * DN_ITEM;
        const bf16_t* Mm = (const bf16_t*)(wsp<float>(p, WS_DM) + mo); const float* Nn = wsp<float>(p, WS_DN) + mo;
#pragma unroll
        for (int mb = 0; mb < 2; ++mb) {
#pragma unroll
            for (int ks = 0; ks < 4; ++ks) a[mb][ks] = *(const bf16x8*)(Mm + (mb * 32 + r32) * 64 + ks * 16 + 8 * hh);
#pragma unroll
            for (int q = 0; q < 16; ++q) n[mb][q] = Nn[(size_t)(mb * 2 + nb) * 1024 + q * 64 + lane]; } };
    load(0, am, nn);
#pragma unroll 1
    for (int step = 0; step < NCH; ++step) {
        if (step + 1 < NCH) load(step + 1, amn, nnn);
        bf16_t* Sd = (bf16_t*)(wsp<float>(p, WS_DS) + ((size_t)((bh * 2 + dir) * NCH + blk_of(step))) * DN_ITEM);
#pragma unroll
        for (int mb = 0; mb < 2; ++mb)
#pragma unroll
            for (int g = 0; g < 4; ++g) *(u32x2*)(Sd + (size_t)(nb * 32 + r32) * 64 + mb * 32 + 8 * g + 4 * hh) = pk[mb][g];
        bf16x8 bs[4];
#pragma unroll
        for (int ks = 0; ks < 4; ++ks) bs[ks] = *(const bf16x8*)(St + r32 * 72 + ks * 16 + 8 * hh);
#pragma unroll
        for (int mb = 0; mb < 2; ++mb) {
#pragma unroll
            for (int ks = 0; ks < 4; ++ks) nn[mb] = __builtin_amdgcn_mfma_f32_32x32x16_bf16(am[mb][ks], bs[ks], nn[mb], 0, 0, 0);
#pragma unroll
            for (int g = 0; g < 4; ++g) { pk[mb][g].x = pk2(nn[mb][4 * g], nn[mb][4 * g + 1]); pk[mb][g].y = pk2(nn[mb][4 * g + 2], nn[mb][4 * g + 3]);
                *(u32x2*)(St + r32 * 72 + mb * 32 + 8 * g + 4 * hh) = pk[mb][g]; } }
#pragma unroll
        for (int mb = 0; mb < 2; ++mb) {
#pragma unroll
            for (int ks = 0; ks < 4; ++ks) am[mb][ks] = amn[mb][ks];
            nn[mb] = nnn[mb]; }
    }
}

DEVI void dn_output(const Params& p, char* lds, int l) {
    const int tid = tid_fresh(), lane = tid & 63, wid = tid >> 6, r32 = lane & 31, hh = lane >> 5;
    const int dir = wid >> 2, wq = wid & 3, mb = wq >> 1, nb = wq & 1, t256 = tid & 255;
    bf16_t* Qr = (bf16_t*)lds; bf16_t* Kr = Qr + 64 * 72; bf16_t* Dm = Kr + 64 * 72 + dir * 4 * 64 * 72;
    bf16_t* Wr = Dm; bf16_t* St = Dm + 64 * 72; bf16_t* At = St + 64 * 72; bf16_t* Vn = At + 64 * 72;
    float* oS = (float*)(Qr + 10 * 64 * 72); float* gcn = oS + 64 * 65 + dir * 64;
    const int NITEM = NB * 4 * NCH;
    const float gdo = p.in[I_DOUTG][l * 64 + lane];
    for (int it = blockIdx.x; it < NITEM; it += gridDim.x) {
        const int blk = it % NCH, bh = it / NCH, b = bh >> 2, h = bh & 3, pos0 = blk * 64;
        if (l == 1 && blk >= 64) continue;
        const size_t mo = ((size_t)((bh * 2 + dir) * NCH + blk)) * DN_ITEM;
        __syncthreads();
        unsigned short gtv[8]; float gdg = 0.f; float uu[16];
        { const int rr = tid >> 3, cc = (tid & 7) * 8;
          const u32x4 gq = *(const u32x4*)(wsp<bf16_t>(p, WS_QD) + ((size_t)bh * KV + pos0) * 64 + tid * 8), gk = *(const u32x4*)(wsp<bf16_t>(p, WS_KD) + ((size_t)bh * KV + pos0) * 64 + tid * 8);
          u32x4 gw[2], gs[2];
#pragma unroll
          for (int q = 0; q < 2; ++q) { const int ci = t256 + q * 256; gw[q] = *(const u32x4*)((const bf16_t*)(wsp<float>(p, WS_DW) + mo) + ci * 8); gs[q] = *(const u32x4*)((const bf16_t*)(wsp<float>(p, WS_DS) + mo) + ci * 8); }
#pragma unroll
          for (int k = 0; k < 8; ++k) gtv[k] = *(const unsigned short*)(wsp<bf16_t>(p, WS_P) + (size_t)bp2row(b, pos0 + wid + 8 * k) * INWP + O_DG + h * 64 + lane);
          if (wq == 0) gdg = wsp<float>(p, WS_DG)[((size_t)(bh * 2 + dir)) * KV + pos0 + (dir ? 63 - lane : lane)];
          { const float* U = wsp<float>(p, WS_DU) + mo + (size_t)(mb * 2 + nb) * 1024;
#pragma unroll
            for (int q = 0; q < 16; ++q) uu[q] = U[q * 64 + lane]; }
          asm volatile("" ::: "memory");
          *(u32x4*)(Qr + rr * 72 + cc) = gq; *(u32x4*)(Kr + rr * 72 + cc) = gk;
#pragma unroll
          for (int q = 0; q < 2; ++q) { const int ci = t256 + q * 256, r2 = ci >> 3, c2 = (ci & 7) * 8; *(u32x4*)(Wr + r2 * 72 + c2) = gw[q]; *(u32x4*)(St + r2 * 72 + c2) = gs[q]; } }
        if (wq == 0) { const int i = dir ? 63 - lane : lane; float g = gdg;
#pragma unroll
            for (int oo = 1; oo < 64; oo <<= 1) { const float t = __shfl_up(g, oo); if (lane >= oo) g += t; }
            gcn[i] = g; }
        __syncthreads();
        {
            f32x16 acc;
#pragma unroll
            for (int q = 0; q < 16; ++q) acc[q] = 0.f;
            mm_tile(acc, Kr, 72, Qr, 72, mb, nb, lane);
            const int i = nb * 32 + r32; const float gci = gcn[i];
#pragma unroll
            for (int q = 0; q < 16; ++q) { const int j = mb * 32 + crow(q, hh); const bool ok = dir ? (j >= i) : (j <= i); acc[q] = ok ? acc[q] * __expf(gci - gcn[j]) : 0.f; }
            tile_store_t(acc, At, 72, mb, nb, lane);
#pragma unroll
            for (int q = 0; q < 16; ++q) acc[q] = 0.f;
            mm_tile(acc, Wr, 72, St, 72, mb, nb, lane);
#pragma unroll
            for (int q = 0; q < 16; ++q) acc[q] = uu[q] - acc[q];
            tile_store_t(acc, Vn, 72, mb, nb, lane); }
        __syncthreads();
        f32x16 o;
        {
            f32x16 t;
#pragma unroll
            for (int q = 0; q < 16; ++q) t[q] = 0.f;
            mm_tile(t, Qr, 72, St, 72, mb, nb, lane);
#pragma unroll
            for (int q = 0; q < 16; ++q) o[q] = t[q] * __expf(gcn[mb * 32 + crow(q, hh)]);
            mm_tile(o, At, 72, Vn, 72, mb, nb, lane); }
        if (dir == 0) {
#pragma unroll
            for (int q = 0; q < 16; ++q) oS[(mb * 32 + crow(q, hh)) * 65 + nb * 32 + r32] = o[q]; }
        __syncthreads();
        if (dir == 1) {
#pragma unroll
            for (int q = 0; q < 16; ++q) oS[(mb * 32 + crow(q, hh)) * 65 + nb * 32 + r32] += o[q]; }
        __syncthreads();
        { float v[8];
#pragma unroll
          for (int k = 0; k < 8; ++k) v[k] = oS[(wid + 8 * k) * 65 + lane];
#pragma unroll
          for (int k = 0; k < 8; ++k) { const int row = bp2row(b, pos0 + wid + 8 * k); const float ss = wave_sum(v[k] * v[k]);
              const float gate = __builtin_bit_cast(float, (unsigned)gtv[k] << 16);
              wsp<unsigned char>(p, WS_Y)[(size_t)row * D + 512 + h * 64 + lane] = (unsigned char)(__builtin_amdgcn_cvt_pk_fp8_f32(clamp8(v[k] * rsqrtf(ss * (1.f / 64.f) + EPS) * gdo * siluf(gate) * S8_ACT), 0.f, 0, false) & 0xff); } }
    }
}

template <int DK> struct AttnW { bf16x8 qf[DK / 16]; f32x16 o[2]; f32x16 negm; float l; };
struct NoAdj { DEVI void operator()(f32x16 (&)[2], int) const {} };
DEVI bf16x8 pack8(float a, float b, float c, float d, float e, float f, float g, float h) { u32x4 w; w.x = pk2(a, b); w.y = pk2(c, d); w.z = pk2(e, f); w.w = pk2(g, h); return __builtin_bit_cast(bf16x8, w); }
DEVI float max3f(float a, float b, float c) { float r; asm("v_max3_f32 %0, %1, %2, %3" : "=v"(r) : "v"(a), "v"(b), "v"(c)); return r; }

template <int DK, int VS, class Adj> DEVI void attn_tile(AttnW<DK>& w, const bf16_t* Ks, const bf16_t* Vts, int lane, const Adj& adj) {
    const int r32 = lane & 31, hh = lane >> 5;
    f32x16 s[2];
#pragma unroll
    for (int kb = 0; kb < 2; ++kb) {
        s[kb] = w.negm;
#pragma unroll
        for (int ks = 0; ks < DK / 16; ++ks) { const bf16x8 kf = *(const bf16x8*)(Ks + (kb * 32 + r32) * (DK + 8) + ks * 16 + 8 * hh);
            s[kb] = __builtin_amdgcn_mfma_f32_32x32x16_bf16(kf, w.qf[ks], s[kb], 0, 0, 0); } }
    adj(s, lane);
#pragma unroll
    for (int kb = 0; kb < 2; ++kb) {
        float mx = max3f(s[kb][0], s[kb][1], s[kb][2]);
#pragma unroll
        for (int i = 3; i < 15; i += 2) mx = max3f(mx, s[kb][i], s[kb][i + 1]);
        mx = fmaxf(mx, s[kb][15]);
        if (!__all(mx <= 8.f)) {
            mx = fmaxf(mx, __shfl_xor(mx, 32));
            const float up = fmaxf(mx, 0.f), alpha = __builtin_amdgcn_exp2f(-up); w.l *= alpha;
#pragma unroll
            for (int i = 0; i < 16; ++i) { w.o[0][i] *= alpha; w.o[1][i] *= alpha; w.negm[i] -= up; s[kb][i] -= up; if (kb == 0) s[1][i] -= up; } }
        float rs = 0.f;
#pragma unroll
        for (int i = 0; i < 16; ++i) { const float pv = __builtin_amdgcn_exp2f(s[kb][i]); s[kb][i] = pv; rs += pv; }
        w.l += rs;
#pragma unroll
        for (int s2 = 0; s2 < 2; ++s2) { const int b8 = 8 * s2;
            const bf16x8 pf = pack8(s[kb][b8], s[kb][b8 + 1], s[kb][b8 + 2], s[kb][b8 + 3], s[kb][b8 + 4], s[kb][b8 + 5], s[kb][b8 + 6], s[kb][b8 + 7]);
#pragma unroll
            for (int db = 0; db < 2; ++db) { const bf16_t* vp = Vts + (db * 32 + r32) * VS + kb * 32 + 16 * s2 + 4 * hh;
                const u32x2 lo = *(const u32x2*)vp, hi = *(const u32x2*)(vp + 8); u32x4 vv; vv.x = lo.x; vv.y = lo.y; vv.z = hi.x; vv.w = hi.y;
                w.o[db] = __builtin_amdgcn_mfma_f32_32x32x16_bf16(__builtin_bit_cast(bf16x8, vv), pf, w.o[db], 0, 0, 0); } }
    }
}
template <int DK> DEVI void attn_init(AttnW<DK>& w, const bf16_t* qrow, int lane) {
#pragma unroll
    for (int ks = 0; ks < DK / 16; ++ks) w.qf[ks] = *(const bf16x8*)(qrow + ks * 16 + 8 * (lane >> 5));
#pragma unroll
    for (int i = 0; i < 16; ++i) { w.o[0][i] = 0.f; w.o[1][i] = 0.f; w.negm[i] = 0.f; }
    w.l = 0.f;
}
template <int DK> DEVI void attn_finish(AttnW<DK>& w, unsigned char* yrow  , int lane) {
    const float lt = w.l + __shfl_xor(w.l, 32), inv = 1.f / lt; const int hh = lane >> 5;
#pragma unroll
    for (int db = 0; db < 2; ++db)
#pragma unroll
        for (int g = 0; g < 4; ++g) { const float sc = inv * S8_ACT;
            *(unsigned*)(yrow + db * 32 + 8 * g + 4 * hh) = pk4_fp8(w.o[db][4 * g] * sc, w.o[db][4 * g + 1] * sc, w.o[db][4 * g + 2] * sc, w.o[db][4 * g + 3] * sc); }
}

template <int DK> DEVI void attn_dense_unit(char* lds, const bf16_t* Q  , const bf16_t* Kh  , const bf16_t* Vth  ,
                                            int qpos0, int tile0, int ntiles, unsigned char* y0  ) {
    const int tid = tid_fresh(), lane = tid & 63, wid = tid >> 6;
    constexpr int KCH = 128 * DK / 8, NKC = KCH / 512;
    constexpr int VS = 132, BUF = 128 * (DK + 8) + 64 * VS;
    bf16_t* base = (bf16_t*)lds;
    AttnW<DK> w; attn_init(w, Q + (size_t)(qpos0 + wid * 32 + (lane & 31)) * DK, lane);
    const int nst = ntiles >> 1;
    u32x4 rk[NKC], rv[2];
    auto prefetch = [&](int st) { const bf16_t* kt = Kh + (size_t)(tile0 + 2 * st) * 64 * DK;
#pragma unroll
        for (int q = 0; q < NKC; ++q) rk[q] = *(const u32x4*)(kt + (q * 512 + tid) * 8);
#pragma unroll
        for (int q = 0; q < 2; ++q) { const int ci = q * 512 + tid; rv[q] = *(const u32x4*)(Vth + (size_t)(ci >> 4) * KV + (tile0 + 2 * st) * 64 + (ci & 15) * 8); } };
    auto stage = [&](int bsel) { bf16_t* Ks = base + bsel * BUF; bf16_t* Vts = Ks + 128 * (DK + 8);
#pragma unroll
        for (int q = 0; q < NKC; ++q) { const int ci = q * 512 + tid, key = ci / (DK / 8), c = ci % (DK / 8); *(u32x4*)(Ks + key * (DK + 8) + c * 8) = rk[q]; }
#pragma unroll
        for (int q = 0; q < 2; ++q) { const int ci = q * 512 + tid; bf16_t* vd = Vts + (ci >> 4) * VS + (ci & 15) * 8; u32x2 a, b; a.x = rv[q].x; a.y = rv[q].y; b.x = rv[q].z; b.y = rv[q].w; *(u32x2*)vd = a; *(u32x2*)(vd + 4) = b; } };
    prefetch(0);
    __syncthreads();
    stage(0);
    if (nst > 1) prefetch(1);
    __syncthreads();
#pragma unroll 1
    for (int st = 0; st < nst; ++st) {
        if (st + 1 < nst) stage((st + 1) & 1);
        if (st + 2 < nst) prefetch(st + 2);
        const bf16_t* Ks = base + (st & 1) * BUF; const bf16_t* Vts = Ks + 128 * (DK + 8);
        attn_tile<DK, VS>(w, Ks, Vts, lane, NoAdj());
        attn_tile<DK, VS>(w, Ks + 64 * (DK + 8), Vts + 64, lane, NoAdj());
        __syncthreads();
    }
    attn_finish<DK>(w, y0 + (size_t)(wid * 32 + (lane & 31)) * D, lane);
}

struct NaAdj { const float* bias;   int c0;
    DEVI void operator()(f32x16 (&s)[2], int lane) const { const int hh = lane >> 5;
#pragma unroll
        for (int kb = 0; kb < 2; ++kb)
#pragma unroll
            for (int i = 0; i < 16; ++i) { const int wl = kb * 32 + (i & 3) + 8 * (i >> 2); const int wk = wl + 4 * hh; const bool ok = wk >= c0 && wk < c0 + 16;
                s[kb][i] = ok ? s[kb][i] + bias[wl] : -1e30f; } } };
DEVI void attn_na_unit(const Params& p, char* lds, int l, int b, int h, int rg) {
    const int tid = tid_fresh(), lane = tid & 63, wid = tid >> 6;
    constexpr int BUF = 64 * 72 + 64 * 68;
    bf16_t* base = (bf16_t*)lds; float* bias = (float*)(base + 2 * BUF);
    const int r = rg * 4 + (wid >> 1), cq = (wid & 1) * 32 + (lane & 31), r0 = min(max(r - 4, 0), GW - 8);
    const int rlo = min(max(rg * 4 - 4, 0), GW - 8), rhi = min(max(rg * 4 + 3 - 4, 0), GW - 8) + 7, nl = rhi - rlo + 1, ntiles = nl + 4;
    const bf16_t* Kh = wsp<bf16_t>(p, WS_KNA) + (size_t)(b * 4 + h) * KV * 64; const bf16_t* Vth = wsp<bf16_t>(p, WS_VTNA) + (size_t)(b * 4 + h) * 64 * KV;
    AttnW<64> w; attn_init(w, wsp<bf16_t>(p, WS_QNA) + ((size_t)(b * 4 + h) * KV + r * 64 + cq) * 64, lane);
    u32x4 rk0, rv;
    auto key0 = [&](int t) { return t < nl ? (rlo + t) * 64 : SEQ + (t - nl) * 64; };
    auto prefetch = [&](int t) { const int k0 = key0(t); rk0 = *(const u32x4*)(Kh + (size_t)k0 * 64 + tid * 8); rv = *(const u32x4*)(Vth + (size_t)(tid >> 3) * KV + k0 + (tid & 7) * 8); };
    auto stage = [&](int bsel) { bf16_t* Ks = base + bsel * BUF; bf16_t* Vts = Ks + 64 * 72; *(u32x4*)(Ks + (tid >> 3) * 72 + (tid & 7) * 8) = rk0;
        bf16_t* vd = Vts + (tid >> 3) * 68 + (tid & 7) * 8; u32x2 a, c; a.x = rv.x; a.y = rv.y; c.x = rv.z; c.y = rv.w; *(u32x2*)vd = a; *(u32x2*)(vd + 4) = c; };
    prefetch(0);
    __syncthreads();
    for (int i = tid; i < 15 * 31; i += NTHREADS) bias[i] = p.in[I_NABIAS][((size_t)l * 4 + h) * 15 * 31 + i] * LOG2E;
    stage(0);
    prefetch(1);
    __syncthreads();
#pragma unroll 1
    for (int t = 0; t < ntiles; ++t) {
        if (t + 1 < ntiles) stage((t + 1) & 1);
        if (t + 2 < ntiles) prefetch(t + 2);
        const bf16_t* Ks = base + (t & 1) * BUF;
        if (t < nl) { const int rr = rlo + t;
            if (rr >= r0 && rr < r0 + 8) { NaAdj adj{bias + (rr - r + 7) * 31 + 15 - cq + 4 * (lane >> 5), min(max(cq - 8, 0), GW - 16)}; attn_tile<64, 68>(w, Ks, Ks + 64 * 72, lane, adj); } }
        else attn_tile<64, 68>(w, Ks, Ks + 64 * 72, lane, NoAdj());
        __syncthreads();
    }
    attn_finish<64>(w, wsp<unsigned char>(p, WS_Y) + (size_t)(b * SEQ + r * 64 + cq) * D + h * 64, lane);
}

#ifndef MIX_DUP
#define MIX_DUP 0
#endif
DEVI void ph_mix(const Params& p, char* lds, int l) {
    { const int tid0 = tid_fresh(), wv = tid0 >> 6; const int first = (int)gridDim.x >= 32 ? (int)gridDim.x - 16 : 0;
      for (int rep = 0; rep < ((MIX_DUP & 8) ? 2 : 1); ++rep)
      for (int wg = (int)blockIdx.x - first; wg >= 0 && wg < 16; wg += gridDim.x) dn_scan_wave(p, lds + wv * 4608, wg * 8 + wv, tid0 & 63); }
    __syncthreads();
    const int per_b = l == 0 ? 204 : 192;
    unsigned char* Y = wsp<unsigned char>(p, WS_Y);
    int* slot = (int*)(lds + 143360);
    unsigned* qctl = wsp<unsigned>(p, WS_CTL) + CW_Q + l * 8 * 64;
    for (int qq = 0; qq < 8; ++qq) {
        const int b = (int)((blockIdx.x + qq) & 7);
        for (;;) {
            __syncthreads();
            if (tid_fresh() == 0) *slot = (int)atomicAdd(qctl + b * 64, 1u);
            __syncthreads();
            const int u = __builtin_amdgcn_readfirstlane(*slot);
            if (u >= per_b * (MIX_DUP ? 2 : 1)) break;
            int v = u % per_b;
            if (MIX_DUP && u >= per_b) { const int kbit = v < 64 ? 2 : v < 128 ? 1 : v < 192 ? 4 : 0; if (!(MIX_DUP & kbit)) continue; }
            if (v >= 128 && v < 192) { attn_na_unit(p, lds, l, b, (v - 128) >> 4, (v - 128) & 15); continue; }
            int kind, h, qpos0, tile0, ntiles; size_t yrow;
            if (v < 64) { kind = 2; h = v >> 4; qpos0 = (v & 15) * 256; tile0 = 0; ntiles = NCH; yrow = (size_t)b * SEQ + qpos0; }
            else if (v < 128) { kind = 1; h = (v - 64) >> 4; qpos0 = (v & 15) * 256; tile0 = 0; ntiles = NCH; yrow = (size_t)b * SEQ + qpos0; }
            else { const int c = v - 192; kind = c >> 2; h = c & 3; qpos0 = SEQ; tile0 = SEQ / 64; ntiles = 4; yrow = (size_t)NLAT + b * CTX; }
            if (kind == 2) attn_dense_unit<96>(lds, wsp<bf16_t>(p, WS_QM) + (size_t)(b * 4 + h) * KV * 96, wsp<bf16_t>(p, WS_KM) + (size_t)(b * 4 + h) * KV * 96,
                                               wsp<bf16_t>(p, WS_VTM) + (size_t)(b * 4 + h) * 64 * KV, qpos0, tile0, ntiles, Y + yrow * D + 768 + h * 64);
            else { const int kvh = kind == 0 ? b * 4 + h : b * 2 + (h >> 1);
                attn_dense_unit<64>(lds, wsp<bf16_t>(p, kind == 0 ? WS_QNA : WS_QG) + (size_t)(b * 4 + h) * KV * 64, wsp<bf16_t>(p, kind == 0 ? WS_KNA : WS_KG) + (size_t)kvh * KV * 64,
                                    wsp<bf16_t>(p, kind == 0 ? WS_VTNA : WS_VTG) + (size_t)kvh * 64 * KV, qpos0, tile0, ntiles, Y + yrow * D + (kind == 0 ? 0 : 256) + h * 64); }
        }
    }
}

DEVI void ph_router(const Params& p, char* lds, int l) {
    const int tid = tid_fresh(), lane = tid & 63, wid = tid >> 6;
    constexpr int RWS = 1028;
    float* rwT = (float*)lds;
    float* hs = (float*)(lds + 32 * RWS * 4) + wid * 512;
    int* lcnt = (int*)(lds + 32 * RWS * 4 + 16384);
    int* sel = wsp<int>(p, WS_SEL);
    const int Mr = l == 0 ? MROWS : NLAT;
    const int per = (((Mr + gridDim.x - 1) / gridDim.x) + 1) & ~1, row_lo = min((int)blockIdx.x * per, Mr), row_hi = min(row_lo + per, Mr);
    __syncthreads();
    for (int i = tid; i < 1024 * 32; i += NTHREADS) rwT[(i & 31) * RWS + (i >> 5)] = p.in[I_RW][(size_t)l * 1024 * 32 + i];
    if (tid < 32) lcnt[tid] = 0;
    __syncthreads();
    const int e = lane & 31, kh = lane >> 5; const float rb = p.in[I_RB][l * 32 + e];
    const float* g2 = p.in[I_N2G] + l * D;
    u32x2 xn[2][4];
    auto fetch = [&](int row) {
#pragma unroll
        for (int rr = 0; rr < 2; ++rr)
#pragma unroll
            for (int i = 0; i < 4; ++i) xn[rr][i] = *(const u32x2*)(wsp<bf16_t>(p, WS_XCUR) + (size_t)(row + rr) * D + i * 256 + lane * 4); };
    f32x4 shv[4], scv[4]; int curb = -1;
#pragma unroll
    for (int i = 0; i < 4; ++i) { shv[i] = (f32x4){0.f, 0.f, 0.f, 0.f}; scv[i] = (f32x4){0.f, 0.f, 0.f, 0.f}; }
    if (row_lo + 2 * wid < row_hi) fetch(row_lo + 2 * wid);
    for (int row = row_lo + 2 * wid; row < row_hi; row += 16) {
        f32x4 v[2][4]; float r[2];
#pragma unroll
        for (int rr = 0; rr < 2; ++rr) { float ss = 0.f;
#pragma unroll
            for (int i = 0; i < 4; ++i) { v[rr][i] = (f32x4){__builtin_bit_cast(float, xn[rr][i].x << 16), __builtin_bit_cast(float, xn[rr][i].x & 0xffff0000u), __builtin_bit_cast(float, xn[rr][i].y << 16), __builtin_bit_cast(float, xn[rr][i].y & 0xffff0000u)};
                ss += v[rr][i][0] * v[rr][i][0] + v[rr][i][1] * v[rr][i][1] + v[rr][i][2] * v[rr][i][2] + v[rr][i][3] * v[rr][i][3]; }
            r[rr] = rsqrtf(wave_sum(ss) * (1.f / 1024.f) + EPS); }
        { const int bt = row < NLAT ? (row >> 12) : 8;
          if (bt != curb) { curb = bt; const float* sh = mod_vec(p, l, row, 3); const float* sc = mod_vec(p, l, row, 4);
#pragma unroll
              for (int i = 0; i < 4; ++i) { shv[i] = *(const f32x4*)(sh + i * 256 + lane * 4); scv[i] = *(const f32x4*)(g2 + i * 256 + lane * 4) * (*(const f32x4*)(sc + i * 256 + lane * 4) + 1.f); } } }
        if (row + 16 < row_hi) fetch(row + 16);
        asm volatile("" ::: "memory");
        float acc[2][2] = {{0.f, 0.f}, {0.f, 0.f}};
#pragma unroll
        for (int i = 0; i < 4; ++i) {
            const int c = i * 256 + lane * 4; const f32x4 s4 = shv[i], c4 = scv[i];
#pragma unroll
            for (int rr = 0; rr < 2; ++rr) { f32x4 y;
#pragma unroll
                for (int j = 0; j < 4; ++j) y[j] = (v[rr][i][j] * r[rr]) * c4[j] + s4[j];
                *(unsigned*)(wsp<unsigned char>(p, WS_HB) + (size_t)(row + rr) * D + c) = pk4_fp8(y[0] * S8_ACT, y[1] * S8_ACT, y[2] * S8_ACT, y[3] * S8_ACT);
                *(f32x4*)(hs + rr * 256 + lane * 4) = y; }
            const float* w0 = rwT + (lane & 15) * RWS + i * 256 + (lane >> 4) * 64; const float* w1 = w0 + 16 * RWS; const float* hq = hs + (lane >> 4) * 64;
#pragma unroll 4
            for (int k4 = 0; k4 < 16; ++k4) { const f32x4 a4 = *(const f32x4*)(w0 + k4 * 4), b4 = *(const f32x4*)(w1 + k4 * 4), h0 = *(const f32x4*)(hq + k4 * 4), h1 = *(const f32x4*)(hq + 256 + k4 * 4);
                acc[0][0] += h0[0] * a4[0] + h0[1] * a4[1] + h0[2] * a4[2] + h0[3] * a4[3]; acc[0][1] += h1[0] * a4[0] + h1[1] * a4[1] + h1[2] * a4[2] + h1[3] * a4[3];
                acc[1][0] += h0[0] * b4[0] + h0[1] * b4[1] + h0[2] * b4[2] + h0[3] * b4[3]; acc[1][1] += h1[0] * b4[0] + h1[1] * b4[1] + h1[2] * b4[2] + h1[3] * b4[3]; }
        }
#pragma unroll
        for (int j = 0; j < 2; ++j)
#pragma unroll
            for (int rr = 0; rr < 2; ++rr) { float t = acc[j][rr]; t += __shfl_xor(t, 16); t += __shfl_xor(t, 32); acc[j][rr] = t; }
#pragma unroll
        for (int rr = 0; rr < 2; ++rr) { const float v0 = __shfl(acc[0][rr], e & 15), v1 = __shfl(acc[1][rr], e & 15); float a = ((e >> 4) ? v1 : v0) + rb;
            unsigned u = __builtin_bit_cast(unsigned, a); u = (u & 0x80000000u) ? ~u : (u | 0x80000000u);
            unsigned key = (u & ~31u) | (unsigned)(31 - e);
            float tv[4]; int ti[4];
#pragma unroll
            for (int k = 0; k < 4; ++k) { unsigned best;
                { int x = (int)key; unsigned t;
                  t = (unsigned)__builtin_amdgcn_update_dpp(0, x, 0xB1, 0xF, 0xF, true); x = (int)((unsigned)x > t ? (unsigned)x : t);
                  t = (unsigned)__builtin_amdgcn_update_dpp(0, x, 0x4E, 0xF, 0xF, true); x = (int)((unsigned)x > t ? (unsigned)x : t);
                  t = (unsigned)__builtin_amdgcn_update_dpp(0, x, 0x141, 0xF, 0xF, true); x = (int)((unsigned)x > t ? (unsigned)x : t);
                  t = (unsigned)__builtin_amdgcn_update_dpp(0, x, 0x140, 0xF, 0xF, true); x = (int)((unsigned)x > t ? (unsigned)x : t);
                  const unsigned r0 = (unsigned)__builtin_amdgcn_readlane(x, 0), r1 = (unsigned)__builtin_amdgcn_readlane(x, 16); best = r0 > r1 ? r0 : r1; }
                ti[k] = 31 - (int)(best & 31u); unsigned ub = best & ~31u; ub = (ub & 0x80000000u) ? (ub & 0x7fffffffu) : ~ub; tv[k] = __builtin_bit_cast(float, ub);
                if (e == ti[k]) key = 0u; }
            const float e1 = __expf(tv[1] - tv[0]), e2 = __expf(tv[2] - tv[0]), e3 = __expf(tv[3] - tv[0]), inv = 1.f / (1.f + e1 + e2 + e3);
            if (lane == 0) { const float gt[4] = {inv, e1 * inv, e2 * inv, e3 * inv};
#pragma unroll
                for (int k = 0; k < 4; ++k) { wsp<float>(p, WS_GATE)[(size_t)(row + rr) * 4 + k] = gt[k]; const int lp = atomicAdd(&lcnt[ti[k]], 1); sel[(size_t)(row + rr) * 4 + k] = ti[k] | (lp << 8); } } }
    }
    __syncthreads();
    if (tid < 32) { const int c = lcnt[tid]; lcnt[tid] = c ? (int)atomicAdd(wsp<unsigned>(p, WS_CTL) + CW_CNT + l * 64 + tid, (unsigned)c) : 0; }
    __syncthreads();
    asm volatile("s_waitcnt vmcnt(0)" ::: "memory");
    __syncthreads();
    for (int i = tid; i < (row_hi - row_lo) * 4; i += NTHREADS) { const int s = sel[(size_t)row_lo * 4 + i], ex = s & 255, lp = s >> 8; wsp<int>(p, WS_LIST)[(size_t)ex * MROWS + lcnt[ex] + lp] = (row_lo + (i >> 2)) * 4 + (i & 3); }
}

#ifndef MOE_ALIGN
#define MOE_ALIGN true
#endif
template <int WHICH> DEVI void ph_moe_gemm(const Params& p, char* lds, int l) {
    int* pre = (int*)(lds + pg8::STAGE_BYTES);
    const unsigned* cnt = wsp<unsigned>(p, WS_CTL) + CW_CNT + l * 64;
    __syncthreads();
    unsigned* cntl = (unsigned*)(lds + pg8::STAGE_BYTES + 512);
    { const int t = tid_fresh() - 64;
      if (t >= 0 && t < 64) { const unsigned c = t < NEXP ? cnt[t] : 0u; const int nt = ((int)c + 255) >> 8; int s = nt;
#pragma unroll
          for (int o = 1; o < 32; o <<= 1) { const int v = __shfl_up(s, o); if (t >= o) s += v; }
          if (t < NEXP) { cntl[t] = c; pre[t] = s - nt; if (t == NEXP - 1) pre[NEXP] = s; } } }
    __syncthreads();
    pg8::MoeSched S; S.pre = pre; S.cnt = cntl; S.list = wsp<int>(p, WS_LIST); S.NT = WHICH == 1 ? 8 : 4; S.total = __builtin_amdgcn_readfirstlane(pre[NEXP]) * S.NT; S.G = gridDim.x; S.c = blockIdx.x; S.rshift = 2;
    if (WHICH == 1) { S.A = (const char*)wsp<unsigned char>(p, WS_HB); S.lda_b = D; S.B = (const char*)(wsp<unsigned char>(p, WS_W1) + (size_t)l * NEXP * 2048 * D); S.ldb_b = D; S.estride_b = (size_t)2048 * D; S.gather = true;
        Epi2H E{wsp<unsigned char>(p, WS_H), p.in[I_B1] + (size_t)l * NEXP * 2048};
        pg8::gemm_phase<true, MOE_ALIGN>((LAS unsigned char*)(LAS char*)lds, D, S, E); }
    else { S.A = (const char*)wsp<unsigned char>(p, WS_H); S.lda_b = DEXP; S.B = (const char*)(wsp<unsigned char>(p, WS_W2) + (size_t)l * NEXP * D * DEXP); S.ldb_b = DEXP; S.estride_b = (size_t)D * DEXP; S.gather = false;
        Epi2Y E{wsp<unsigned char>(p, WS_YEXP), p.in[I_B2] + (size_t)l * NEXP * D, wsp<int>(p, WS_LIST), pre};
        pg8::gemm_phase<true, MOE_ALIGN>((LAS unsigned char*)(LAS char*)lds, DEXP, S, E); }
}

DEVI void ph_combine(const Params& p, int l) {
    const int tid = tid_fresh(), lane = tid & 63, gw = blockIdx.x * 8 + (tid >> 6), nw = gridDim.x * 8; const int Mr = l == 0 ? MROWS : NLAT;
    for (int row0 = gw * 2; row0 < Mr; row0 += nw * 2) {
        f32x4 xo[2][4];
#pragma unroll
        for (int rr = 0; rr < 2; ++rr) { const int row = row0 + rr;
            const bf16_t* x = wsp<bf16_t>(p, WS_XCUR) + (size_t)row * D; const float* g5 = mod_vec(p, l, row, 5); const float* gt = wsp<float>(p, WS_GATE) + (size_t)row * 4;
            const unsigned char* ye = wsp<unsigned char>(p, WS_YEXP) + (size_t)row * 4 * D; const f32x4 gg = *(const f32x4*)gt * (1.f / S8_Y);
#pragma unroll
            for (int i = 0; i < 4; ++i) { const int c = i * 256 + lane * 4; f32x4 f = (f32x4){0.f, 0.f, 0.f, 0.f};
#pragma unroll
                for (int k = 0; k < 4; ++k) { const int w = *(const int*)(ye + (size_t)k * D + c); const float g = gg[k];
                    const f32x2_t lo = __builtin_amdgcn_cvt_pk_f32_fp8(w, false), hi = __builtin_amdgcn_cvt_pk_f32_fp8(w, true);
                    f[0] += g * lo[0]; f[1] += g * lo[1]; f[2] += g * hi[0]; f[3] += g * hi[1]; }
                const u32x2 xw = *(const u32x2*)(x + c); const f32x4 xv = (f32x4){__builtin_bit_cast(float, xw.x << 16), __builtin_bit_cast(float, xw.x & 0xffff0000u), __builtin_bit_cast(float, xw.y << 16), __builtin_bit_cast(float, xw.y & 0xffff0000u)};
                xo[rr][i] = xv + *(const f32x4*)(g5 + c) * f; } }
#pragma unroll
        for (int rr = 0; rr < 2; ++rr) { const int row = row0 + rr;
#pragma unroll
            for (int i = 0; i < 4; ++i) { if (l == 0) { u32x2 w; w.x = pk2(xo[rr][i][0], xo[rr][i][1]); w.y = pk2(xo[rr][i][2], xo[rr][i][3]); *(u32x2*)(wsp<bf16_t>(p, WS_XCUR) + (size_t)row * D + i * 256 + lane * 4) = w; }
                else *(f32x4*)(p.out + (size_t)row * D + i * 256 + lane * 4) = xo[rr][i]; }
            if (l == 0) {
                float ss = 0.f;
#pragma unroll
                for (int i = 0; i < 4; ++i) ss += xo[rr][i][0] * xo[rr][i][0] + xo[rr][i][1] * xo[rr][i][1] + xo[rr][i][2] * xo[rr][i][2] + xo[rr][i][3] * xo[rr][i][3];
                ss = wave_sum(ss); const float r = rsqrtf(ss * (1.f / 1024.f) + EPS);
                const float* g = p.in[I_N1G] + D; const float* sh = mod_vec(p, 1, row, 0); const float* sc = mod_vec(p, 1, row, 1); unsigned char* out = wsp<unsigned char>(p, WS_HB) + (size_t)row * D;
#pragma unroll
                for (int i = 0; i < 4; ++i) { const int c = i * 256 + lane * 4; const f32x4 gg = *(const f32x4*)(g + c), s4 = *(const f32x4*)(sh + c), c4 = *(const f32x4*)(sc + c); float y[4];
#pragma unroll
                    for (int j = 0; j < 4; ++j) y[j] = (xo[rr][i][j] * r * gg[j]) * (1.f + c4[j]) + s4[j];
                    *(unsigned*)(out + c) = pk4_fp8(y[0] * S8_ACT, y[1] * S8_ACT, y[2] * S8_ACT, y[3] * S8_ACT); } } }
    }
}

constexpr int N_PHASES = 22;
template <int PH> DEVI void run_phase(const Params& p, char* lds) {
    if constexpr (PH == 0) ph_prologue(p, lds);
    else if constexpr (PH == 1) ph_norm1_l0(p);
    else { constexpr int l = (PH - 2) / 10, q = (PH - 2) % 10;
        if constexpr (q == 0) ph_inproj(p, lds, l);
        else if constexpr (q == 1) ph_post(p, lds, l);
        else if constexpr (q == 2) dn_chunk_local(p, lds, l);
        else if constexpr (q == 3) ph_mix(p, lds, l);
        else if constexpr (q == 4) dn_output(p, lds, l);
        else if constexpr (q == 5) ph_outproj(p, lds, l);
        else if constexpr (q == 6) ph_router(p, lds, l);
        else if constexpr (q == 7) ph_moe_gemm<1>(p, lds, l);
        else if constexpr (q == 8) ph_moe_gemm<2>(p, lds, l);
        else ph_combine(p, l);
    }
}

template <int PH> __global__ void __launch_bounds__(NTHREADS, 2) k_phase(Params p) {
    extern __shared__ __attribute__((aligned(16))) char smem[];
    run_phase<PH>(p, smem);
}

#ifndef PROBE_MASK
#define PROBE_MASK 0u
#endif
DEVI void grid_barrier(const Params& p, char* smem) {
    XcdBarrier b; b.bar = wsp<unsigned>(p, WS_CTL) + CW_BAR; b.x = xb_xcc_id(); b.st = (volatile LAS unsigned*)(LAS char*)(smem + LDS_BYTES - 16);
    xcd_barrier(b);
}
typedef const __attribute__((address_space(4))) Params CParams;
DEVI const Params& kargs() { CParams* k = (CParams*)__builtin_amdgcn_kernarg_segment_ptr(); asm volatile("" : "+s"(k)); return *(const Params*)k; }
template <int PH> DEVI void mega_seq(char* smem) {
    if constexpr (((PROBE_MASK) >> PH) & 1u) { run_phase<PH>(kargs(), smem); grid_barrier(kargs(), smem); }
    run_phase<PH>(kargs(), smem);
    if constexpr (PH + 1 < N_PHASES) { grid_barrier(kargs(), smem); mega_seq<PH + 1>(smem); }
}
__global__ void __launch_bounds__(NTHREADS, 2) k_mega(Params p) {
    extern __shared__ __attribute__((aligned(16))) char smem[];
    volatile LAS unsigned* st = (volatile LAS unsigned*)(LAS char*)(smem + LDS_BYTES - 16);
    if (threadIdx.x == 0) { st[0] = 0u; st[1] = 0u; st[2] = 0u; st[3] = 0u; }
    __syncthreads();
    (void)xcd_barrier_post(wsp<unsigned>(p, WS_CTL) + CW_BAR, st);
    mega_seq<0>(smem);
}

template <int PH> void launch_phase(const Params& p, int grid, hipStream_t s) {
    static bool attr = false;
    if (!attr) { (void)hipFuncSetAttribute((const void*)k_phase<PH>, hipFuncAttributeMaxDynamicSharedMemorySize, LDS_BYTES); attr = true; }
    hipLaunchKernelGGL(k_phase<PH>, dim3(grid), dim3(NTHREADS), LDS_BYTES, s, p);
}
template <int PH> void launch_all(const Params& p, int grid, hipStream_t s) { launch_phase<PH>(p, grid, s); if constexpr (PH + 1 < N_PHASES) launch_all<PH + 1>(p, grid, s); }
}

extern "C" void kernel_launch(void* const* d_in, const int* in_sizes, int n_in, void* d_out, int out_size, void* d_ws, size_t ws_size, hipStream_t stream) {
    (void)in_sizes; (void)out_size;
    static int grid = 0;
    if (grid == 0) {
        if (n_in != N_IN || ws_size < WS_TOTAL) { fprintf(stderr, "kernel_launch: unexpected inputs/workspace (n_in %d, ws %zu < %zu)\n", n_in, ws_size, (size_t)WS_TOTAL); grid = -1; return; }
        int dev = 0, cus = 0, per_cu = 0;
        (void)hipGetDevice(&dev); (void)hipDeviceGetAttribute(&cus, hipDeviceAttributeMultiprocessorCount, dev);
        (void)hipFuncSetAttribute((const void*)k_mega, hipFuncAttributeMaxDynamicSharedMemorySize, LDS_BYTES);
        if (hipOccupancyMaxActiveBlocksPerMultiprocessor(&per_cu, (const void*)k_mega, NTHREADS, LDS_BYTES) != hipSuccess || per_cu < 1) { fprintf(stderr, "kernel_launch: occupancy query says %d\n", per_cu); per_cu = 1; }
        (void)hipGetLastError();
        grid = cus > 0 ? cus : 256;
    }
    if (grid < 0) return;
    Params p{};
    for (int i = 0; i < N_IN; ++i) p.in[i] = (const float*)d_in[i];
    p.out = (float*)d_out; p.ws = (unsigned char*)d_ws; p.ph_lo = 0; p.ph_hi = N_PHASES;
    (void)hipMemsetAsync(d_ws, 0, CTL_BYTES, stream);
#if N_LAUNCH_MODE == 0
    launch_all<0>(p, grid, stream);
#else
    hipLaunchKernelGGL(k_mega, dim3(grid), dim3(NTHREADS), LDS_BYTES, stream, p);
#endif
}
```
